# Optimizing an MI355X kernel written in HIP

```python
import jax
import jax.numpy as jnp
from jax import lax
import numpy as np

D_MODEL = 1024
BATCH = 4
SEQ = 8192
DEPTH = 1

ATT_GROUPS = ((128, 1), (512, 4), (2048, 16))
ATT_HEADS_PER_GROUP = 4
ATT_HEADS = ATT_HEADS_PER_GROUP * len(ATT_GROUPS)
ATT_HEAD_DIM = 128
ATT_BLOCK = 128
ATT_W = ATT_HEADS * ATT_HEAD_DIM
ATT_OUT_W = ATT_HEADS_PER_GROUP * ATT_HEAD_DIM
RET_HEADS = 4
RET_QK_DIM = D_MODEL // RET_HEADS
RET_V_DIM = 2 * D_MODEL // RET_HEADS
RET_QK_W = RET_HEADS * RET_QK_DIM
RET_V_W = RET_HEADS * RET_V_DIM
RET_CHUNK = 128
D_FF = 4 * D_MODEL
IN_SPLITS = (ATT_W, ATT_W, ATT_W, RET_QK_W, RET_QK_W, RET_V_W, RET_V_W, D_MODEL, D_MODEL)
IN_W = sum(IN_SPLITS)
EPS = 1e-6

kernel_name = 'hybrid_dilated_attention_retention_block'


def rmsnorm(x, g):
    xf = x.astype(jnp.float32)
    y = xf * lax.rsqrt(jnp.mean(xf * xf, axis=-1, keepdims=True) + EPS)
    return (y * g.astype(jnp.float32)).astype(x.dtype)


def alibi_slopes(n_heads):
    return jnp.asarray(2.0 ** (-8.0 * np.arange(1, n_heads + 1, dtype=np.float32) / n_heads), dtype=jnp.float32)


def dilated_group(q, k, v, slopes, window, dilation):
    B, S, H, Dh = q.shape
    span = dilation * ATT_BLOCK
    s_pad = -(-S // span) * span
    L = s_pad // dilation
    nb = L // ATT_BLOCK
    reach = window // dilation

    def to_blocks(t):
        t = jnp.pad(t, ((0, 0), (0, s_pad - S), (0, 0), (0, 0)))
        t = t.reshape(B, L, dilation, H, Dh).transpose(0, 2, 3, 1, 4)
        return t.reshape(B, dilation, H, nb, ATT_BLOCK, Dh)

    def with_prev(t):
        prev = jnp.pad(t, ((0, 0), (0, 0), (0, 0), (1, 0), (0, 0), (0, 0)))[:, :, :, :-1]
        return jnp.concatenate([prev, t], axis=4)

    qb = to_blocks(q)
    kb = with_prev(to_blocks(k))
    vb = with_prev(to_blocks(v))
    s = jnp.einsum('brhnqd,brhnkd->brhnqk', qb, kb, preferred_element_type=jnp.float32) * (Dh ** -0.5)
    qi = jnp.arange(ATT_BLOCK)[:, None]
    kj = jnp.arange(2 * ATT_BLOCK)[None, :]
    dist = ATT_BLOCK + qi - kj
    blk = jnp.arange(nb)[:, None, None]
    valid = (dist >= 0) & (dist <= reach) & ((blk - 1) * ATT_BLOCK + kj >= 0)
    bias = -slopes[:, None, None] * (dist * dilation).astype(jnp.float32)
    s = jnp.where(valid[None, None, None], s + bias[None, None, :, None], -jnp.inf)
    m = jnp.max(s, axis=-1)
    p = jnp.exp(s - m[..., None])
    den = jnp.sum(p, axis=-1)
    o = jnp.einsum('brhnqk,brhnkd->brhnqd', p, vb.astype(jnp.float32)) / den[..., None]
    lse = m + jnp.log(den)
    o = o.reshape(B, dilation, H, L, Dh).transpose(0, 3, 1, 2, 4).reshape(B, s_pad, H, Dh)[:, :S]
    lse = lse.reshape(B, dilation, H, L).transpose(0, 3, 1, 2).reshape(B, s_pad, H)[:, :S]
    return o, lse


def retention(q, k, v):
    B, S, H, dk = q.shape
    dv = v.shape[-1]
    C = RET_CHUNK
    N = S // C
    log_g = jnp.log(1.0 - 2.0 ** (-5.0 - jnp.arange(H, dtype=jnp.float32)))
    idx = jnp.arange(C, dtype=jnp.float32)
    diff = idx[:, None] - idx[None, :]
    decay = jnp.where(diff >= 0, jnp.exp(log_g[:, None, None] * jnp.maximum(diff, 0.0)), 0.0)
    xi = jnp.exp(log_g[None, :] * (idx[:, None] + 1.0))
    zeta = jnp.exp(log_g[None, :] * (C - 1.0 - idx[:, None]))
    g_chunk = jnp.exp(log_g * C)
    qc = q.astype(jnp.float32).reshape(B, N, C, H, dk)
    kc = (k.astype(jnp.float32) * (dk ** -0.5)).reshape(B, N, C, H, dk)
    vc = v.astype(jnp.float32).reshape(B, N, C, H, dv)
    s = jnp.einsum('bnqhd,bnkhd->bnhqk', qc, kc) * decay[None, None]
    inner = jnp.einsum('bnhqk,bnkhv->bnqhv', s, vc)
    kz = kc * zeta[None, None, :, :, None]

    def step(state, xs):
        q_i, kz_i, v_i = xs
        cross = jnp.einsum('bqhd,bhdv->bqhv', q_i, state)
        state = state * g_chunk[None, :, None, None] + jnp.einsum('bkhd,bkhv->bhdv', kz_i, v_i)
        return state, cross

    state0 = jnp.zeros((B, H, dk, dv), jnp.float32)
    _, cross = lax.scan(step, state0, (qc.transpose(1, 0, 2, 3, 4), kz.transpose(1, 0, 2, 3, 4), vc.transpose(1, 0, 2, 3, 4)))
    cross = cross.transpose(1, 0, 2, 3, 4) * xi[None, None, :, :, None]
    return (inner + cross).reshape(B, S, H, dv)


def head_groupnorm(o, g, b):
    B, S, H, dv = o.shape
    mu = jnp.mean(o, axis=-1, keepdims=True)
    var = jnp.mean(jnp.square(o - mu), axis=-1, keepdims=True)
    y = ((o - mu) * lax.rsqrt(var + EPS)).reshape(B, S, H * dv)
    return y * g.astype(jnp.float32) + b.astype(jnp.float32)


def setup_inputs(seed: int = 0) -> dict:
    key = jax.random.key(seed)
    ks = jax.random.split(key, 14)

    def nrm(k, shape, scale):
        return scale * jax.random.normal(k, shape, jnp.float32)

    return {
        'x': nrm(ks[0], (BATCH, SEQ, D_MODEL), 1.0),
        'norm1_g': 1.0 + nrm(ks[1], (DEPTH, D_MODEL), 0.02),
        'w_in': nrm(ks[2], (DEPTH, D_MODEL, IN_W), D_MODEL ** -0.5),
        'q_norm_g': 1.0 + nrm(ks[3], (DEPTH, ATT_HEADS, ATT_HEAD_DIM), 0.02),
        'k_norm_g': 1.0 + nrm(ks[4], (DEPTH, ATT_HEADS, ATT_HEAD_DIM), 0.02),
        'ret_gn_g': 1.0 + nrm(ks[5], (DEPTH, RET_V_W), 0.02),
        'ret_gn_b': nrm(ks[6], (DEPTH, RET_V_W), 0.02),
        'w_proj_a': nrm(ks[7], (DEPTH, ATT_OUT_W, D_MODEL), ATT_OUT_W ** -0.5),
        'w_proj_b': nrm(ks[8], (DEPTH, RET_V_W, D_MODEL), RET_V_W ** -0.5),
        'w_out': nrm(ks[9], (DEPTH, D_MODEL, D_MODEL), D_MODEL ** -0.5),
        'norm2_g': 1.0 + nrm(ks[10], (DEPTH, D_MODEL), 0.02),
        'w_up': nrm(ks[11], (DEPTH, D_MODEL, D_FF), D_MODEL ** -0.5),
        'w_down': nrm(ks[12], (DEPTH, D_FF, D_MODEL), D_FF ** -0.5),
    }


def reference(x, norm1_g, w_in, q_norm_g, k_norm_g, ret_gn_g, ret_gn_b, w_proj_a, w_proj_b, w_out, norm2_g, w_up, w_down):
    B, S, _ = x.shape
    slopes = alibi_slopes(ATT_HEADS)
    bounds = np.cumsum((0,) + IN_SPLITS).tolist()
    for l in range(DEPTH):
        xn = rmsnorm(x, norm1_g[l])
        wl = w_in[l]
        qa, ka, va, qr, kr, vr, gr, gate_a, gate_b = [xn @ wl[:, bounds[i]:bounds[i + 1]] for i in range(len(IN_SPLITS))]
        qa = rmsnorm(qa.reshape(B, S, ATT_HEADS, ATT_HEAD_DIM), q_norm_g[l])
        ka = rmsnorm(ka.reshape(B, S, ATT_HEADS, ATT_HEAD_DIM), k_norm_g[l])
        va = va.reshape(B, S, ATT_HEADS, ATT_HEAD_DIM)
        outs, lses = [], []
        for gi, (window, dilation) in enumerate(ATT_GROUPS):
            hs = slice(gi * ATT_HEADS_PER_GROUP, (gi + 1) * ATT_HEADS_PER_GROUP)
            o, lse = dilated_group(qa[:, :, hs], ka[:, :, hs], va[:, :, hs], slopes[hs], window, dilation)
            outs.append(o)
            lses.append(lse)
        alpha = jax.nn.softmax(jnp.stack(lses, axis=0), axis=0)
        o_a = jnp.sum(alpha[..., None] * jnp.stack(outs, axis=0), axis=0).reshape(B, S, ATT_OUT_W).astype(x.dtype)
        o_r = retention(qr.reshape(B, S, RET_HEADS, RET_QK_DIM), kr.reshape(B, S, RET_HEADS, RET_QK_DIM),
                        vr.reshape(B, S, RET_HEADS, RET_V_DIM))
        o_r = (head_groupnorm(o_r, ret_gn_g[l], ret_gn_b[l]) * jax.nn.silu(gr.astype(jnp.float32))).astype(x.dtype)
        y = jax.nn.sigmoid(gate_a) * (o_a @ w_proj_a[l]) + jax.nn.sigmoid(gate_b) * (o_r @ w_proj_b[l])
        x = x + y @ w_out[l]
        xn2 = rmsnorm(x, norm2_g[l])
        x = x + jnp.square(jax.nn.relu(xn2 @ w_up[l])) @ w_down[l]
    return x
```

```cpp
#include <hip/hip_runtime.h>
#include <hip/hip_cooperative_groups.h>
#include <cstdio>
#ifndef REP_A
#define REP_A 1
#endif
#ifndef REP_B1
#define REP_B1 1
#endif
#ifndef REP_B3
#define REP_B3 1
#endif
#ifndef REP_SYNC
#define REP_SYNC 1
#endif
namespace cg = cooperative_groups;

#define LAS __attribute__((address_space(3)))
typedef unsigned short bf16_t;
typedef short bf16x8 __attribute__((ext_vector_type(8)));
typedef float f32x4 __attribute__((ext_vector_type(4)));
typedef unsigned u32x4 __attribute__((ext_vector_type(4)));
typedef unsigned u32x2 __attribute__((ext_vector_type(2)));

constexpr int MT = 32768, TB = 8192, DM = 1024, INW = 12800, DFF = 4096;
constexpr int QKVR_LD = 8704;
constexpr int C_AQ = 0, C_AK = 1536, C_AV = 3072, C_RQ = 4608, C_RK = 5632, C_RV = 6656;
constexpr float EPS = 1e-6f;
constexpr int LDS_BYTES = 139264;
constexpr int PA = 272;
constexpr int PR = 528;

constexpr size_t MiB = 1024 * 1024;
constexpr size_t WS_WIN = 0;
constexpr size_t WS_WPA = WS_WIN + 25 * MiB;
constexpr size_t WS_WPB = WS_WPA + 1 * MiB;
constexpr size_t WS_WOUT = WS_WPB + 4 * MiB;
constexpr size_t WS_WUP = WS_WOUT + 2 * MiB;
constexpr size_t WS_WDN = WS_WUP + 8 * MiB;
constexpr size_t WS_RSTD1 = WS_WDN + 8 * MiB;
constexpr size_t WS_BAR = WS_RSTD1 + 512 * 1024;
constexpr size_t WS_SS2 = WS_RSTD1 + 1 * MiB;
constexpr size_t WS_LSE = WS_SS2 + 2 * MiB;
constexpr size_t WS_OG = WS_LSE + 1 * MiB;
constexpr size_t WS_KV = WS_OG + 24 * MiB;
constexpr size_t WS_R0 = WS_KV + 64 * MiB;
constexpr size_t WS_GR = WS_R0 + 136 * MiB;
constexpr size_t WS_R1 = WS_R0 + 168 * MiB;
constexpr size_t WS_OA = WS_R1;
constexpr size_t WS_OR = WS_R1 + 32 * MiB;
constexpr size_t WS_END = WS_R1 + 160 * MiB;
constexpr size_t WS_X1B = WS_R0;
constexpr size_t WS_Y = WS_R0 + 64 * MiB;
constexpr size_t WS_H = WS_R0 + 64 * MiB;

struct Params {
    const float* x; const float* norm1_g; const float* w_in; const float* q_norm_g; const float* k_norm_g;
    const float* gn_g; const float* gn_b; const float* w_pa; const float* w_pb; const float* w_out;
    const float* norm2_g; const float* w_up; const float* w_dn;
    float* out; unsigned char* ws;
};

__device__ __forceinline__ int lane_id_() { int l; asm volatile("v_mbcnt_lo_u32_b32 %0, -1, 0\n\tv_mbcnt_hi_u32_b32 %0, -1, %0" : "=v"(l)); return l; }
#define TIDX (wv * 64 + lane_id_())
__device__ __forceinline__ float shx(float v, int lane, int mask) { return __int_as_float(__builtin_amdgcn_ds_bpermute((lane ^ mask) << 2, __float_as_int(v))); }
__device__ __forceinline__ float shl(float v, int src) { return __int_as_float(__builtin_amdgcn_ds_bpermute(src << 2, __float_as_int(v))); }
__device__ __forceinline__ unsigned cvt_pk_bf16(float lo, float hi) { unsigned r; asm volatile("v_cvt_pk_bf16_f32 %0, %1, %2" : "=v"(r) : "v"(lo), "v"(hi)); return r; }
__device__ __forceinline__ float bflo(unsigned u) { return __uint_as_float(u << 16); }
__device__ __forceinline__ float bfhi(unsigned u) { return __uint_as_float(u & 0xffff0000u); }
__device__ __forceinline__ float bf2f(bf16_t b) { return __uint_as_float(((unsigned)b) << 16); }
__device__ __forceinline__ bf16_t f2bf(float f) { return (bf16_t)(cvt_pk_bf16(f, 0.f) & 0xffffu); }
__device__ __forceinline__ float sigmoidf_(float v) { return __builtin_amdgcn_rcpf(1.0f + __expf(-v)); }
union Frag { bf16x8 v; u32x4 u; };

__device__ __forceinline__ bf16x8 tr_frag(unsigned a0, unsigned a1) {
    u32x2 r0, r1;
    asm volatile("ds_read_b64_tr_b16 %0, %2\n\tds_read_b64_tr_b16 %1, %3\n\ts_waitcnt lgkmcnt(0)" : "=&v"(r0), "=&v"(r1) : "v"(a0), "v"(a1) : "memory");
    Frag f; f.u = (u32x4){r0.x, r0.y, r1.x, r1.y}; return f.v;
}
__device__ __forceinline__ void tr_frag4(unsigned a0, unsigned a1, unsigned d0, unsigned d1, unsigned d2, unsigned d3, bf16x8& f0, bf16x8& f1, bf16x8& f2, bf16x8& f3) {
    u32x2 r0, r1, r2, r3, r4, r5, r6, r7;
    const unsigned x0 = a0 + d0, y0 = a1 + d0, x1 = a0 + d1, y1 = a1 + d1, x2 = a0 + d2, y2 = a1 + d2, x3 = a0 + d3, y3 = a1 + d3;
    asm volatile("ds_read_b64_tr_b16 %0, %8\n\tds_read_b64_tr_b16 %1, %9\n\tds_read_b64_tr_b16 %2, %10\n\tds_read_b64_tr_b16 %3, %11\n\t"
                 "ds_read_b64_tr_b16 %4, %12\n\tds_read_b64_tr_b16 %5, %13\n\tds_read_b64_tr_b16 %6, %14\n\tds_read_b64_tr_b16 %7, %15\n\ts_waitcnt lgkmcnt(0)"
                 : "=&v"(r0), "=&v"(r1), "=&v"(r2), "=&v"(r3), "=&v"(r4), "=&v"(r5), "=&v"(r6), "=&v"(r7)
                 : "v"(x0), "v"(y0), "v"(x1), "v"(y1), "v"(x2), "v"(y2), "v"(x3), "v"(y3) : "memory");
    Frag f; f.u = (u32x4){r0.x, r0.y, r1.x, r1.y}; f0 = f.v; f.u = (u32x4){r2.x, r2.y, r3.x, r3.y}; f1 = f.v;
    f.u = (u32x4){r4.x, r4.y, r5.x, r5.y}; f2 = f.v; f.u = (u32x4){r6.x, r6.y, r7.x, r7.y}; f3 = f.v;
}
#define MFMA16(a, b, c) __builtin_amdgcn_mfma_f32_16x16x32_bf16((a), (b), (c), 0, 0, 0)

namespace pg8 {
constexpr int BM = 256, BK = 64, HALF = 128, HTB = HALF * BK * 2, STAGE_BYTES = 8 * HTB, NXCD = 8, WGM = 8;
__device__ __forceinline__ int lds_byte(int r, int c) { const int st = (r >> 4) * 2 + (c >> 5), rr = r & 15, cc = c & 31, ob = rr * 64 + cc * 2; return st * 1024 + (ob ^ (((ob >> 9) & 1) << 5)); }
__device__ __forceinline__ void stage_rc(int b, int& R, int& C) { const int st = b / 1024, sb = b % 1024, swz = sb ^ (((sb >> 9) & 1) << 5); R = (st >> 1) * 16 + swz / 64; C = (st & 1) * 32 + (swz % 64) / 2; }
__device__ __forceinline__ int perm32(int rho) { const int n = rho >> 4, i = rho & 15; return 8 * (i >> 2) + 4 * n + (i & 3); }
struct Unit { int pm, pn; };
struct Gemm { const bf16_t* A; const bf16_t* Bt; int M, N, K, lda, ldb; };
struct StaticOrder {
    int nM, nN, nwg, G, c;
    __device__ void init(int M, int N, int G_, int c_) { nM = M / BM; nN = N / BM; nwg = nM * nN; G = G_; c = c_; }
    __device__ bool next(int i, Unit& u) const {
        const long L = (long)i * G + c; if (L >= nwg) return false;
        int wgid = (int)L; { const int q = nwg / NXCD, r = nwg % NXCD, xcd = wgid % NXCD, off = wgid / NXCD; wgid = (xcd < r ? xcd * (q + 1) : r * (q + 1) + (xcd - r) * q) + off; }
        const int nig = WGM * nN, gid = wgid / nig, fm = gid * WGM, gsz = (nM - fm) < WGM ? (nM - fm) : WGM;
        u.pm = fm + ((wgid % nig) % gsz); u.pn = (wgid % nig) / gsz; return true;
    }
    __device__ __forceinline__ void a_ready(const Unit&) const {}
    __device__ __forceinline__ void done(const Unit&) const {}
};

template <class Epi, class Sched>
__device__ __forceinline__ void gemm_phase(const int wv, LAS unsigned char* lds, const Gemm g, const Sched& S, const Epi& E) {
    int tid_ = TIDX; asm volatile("" : "+v"(tid_));
    const int tid = tid_, wid = __builtin_amdgcn_readfirstlane(tid >> 6), lane = tid & 63, wr = wid >> 2, wc = wid & 3, fr = lane & 15, fq = lane >> 4;
    const int K = g.K, nt = K / BK;
    unsigned voffA[2], voffB[2];
#pragma unroll
    for (int i = 0; i < 2; ++i) { int R, C; stage_rc(tid * 16 + i * 8192, R, C); const int Rb = Epi::PERM ? ((R & ~31) + perm32(R & 31)) : R;
        voffA[i] = (unsigned)(R * g.lda + C) * 2u; voffB[i] = (unsigned)(Rb * g.ldb + C) * 2u; }
    const size_t kstep = (size_t)(BK * 2);
    const size_t hstepA = (size_t)HALF * g.lda * 2, hstepB = (size_t)HALF * g.ldb * 2;
    const size_t tstepA = 2 * hstepA, tstepB = 2 * hstepB;
    const unsigned ldsw = (unsigned)wid * 1024u;
    const int aoff = lds_byte(wr * 64 + fr, fq * 8), boff = lds_byte(wc * 32 + fr, fq * 8);
#define PG8_SA(b, h) (((b) * 2 + (h)) * HTB)
#define PG8_SB(b, h) ((4 + (b) * 2 + (h)) * HTB)
#define PG8_STAGE(bufoff, gbase, voff) do { _Pragma("unroll") for (int _i = 0; _i < 2; ++_i) \
        __builtin_amdgcn_global_load_lds((const unsigned*)((const char*)(gbase) + (voff)[_i]), (LAS unsigned*)(lds + (bufoff) + ldsw + _i * 8192), 16, 0, 0); } while (0)
#define PG8_LDA(dst, b, h) do { _Pragma("unroll") for (int m = 0; m < 4; ++m) _Pragma("unroll") for (int k = 0; k < 2; ++k) dst[m][k] = *(const LAS bf16x8*)(lds + PG8_SA(b, h) + aoff + m * 2048 + k * 1024); } while (0)
#define PG8_LDB(dst, b, h) do { _Pragma("unroll") for (int n = 0; n < 2; ++n) _Pragma("unroll") for (int k = 0; k < 2; ++k) dst[n][k] = *(const LAS bf16x8*)(lds + PG8_SB(b, h) + boff + n * 2048 + k * 1024); } while (0)
#define PG8_MMA(ai, bj, At, Bt) do { __builtin_amdgcn_s_setprio(1); _Pragma("unroll") for (int m = 0; m < 4; ++m) _Pragma("unroll") for (int n = 0; n < 2; ++n) _Pragma("unroll") for (int k = 0; k < 2; ++k) \
        acc[ai][bj][m][n] = __builtin_amdgcn_mfma_f32_16x16x32_bf16(Bt[n][k], At[m][k], acc[ai][bj][m][n], 0, 0, 0); __builtin_amdgcn_s_setprio(0); } while (0)
#define PG8_WAIT_V(n) asm volatile("s_waitcnt vmcnt(" #n ")" ::: "memory")
#define PG8_WAIT_L(n) asm volatile("s_waitcnt lgkmcnt(" #n ")" ::: "memory")
#define PG8_BAR __builtin_amdgcn_s_barrier()
#define PG8_SCHED __builtin_amdgcn_sched_barrier(0)
    Unit cur, nxt; int ui = 0;
    if (!S.next(0, cur)) return;
    f32x4 acc[2][2][4][2];
#pragma unroll
    for (int a = 0; a < 2; ++a)
#pragma unroll
        for (int b = 0; b < 2; ++b)
#pragma unroll
            for (int m = 0; m < 4; ++m)
#pragma unroll
                for (int n = 0; n < 2; ++n) acc[a][b][m][n] = (f32x4){0.f, 0.f, 0.f, 0.f};
    bf16x8 At[4][2], B0[2][2], B1[2][2];
    const char* cA = (const char*)g.A + (size_t)cur.pm * tstepA; const char* cB = (const char*)g.Bt + (size_t)cur.pn * tstepB;
    S.a_ready(cur);
    PG8_STAGE(PG8_SB(0, 0), cB, voffB); PG8_STAGE(PG8_SA(0, 0), cA, voffA); PG8_STAGE(PG8_SB(0, 1), cB + hstepB, voffB); PG8_STAGE(PG8_SA(0, 1), cA + hstepA, voffA);
    if (wr == 1) PG8_BAR;
    PG8_WAIT_V(4); PG8_BAR;
    PG8_STAGE(PG8_SB(1, 0), cB + kstep, voffB); PG8_STAGE(PG8_SA(1, 0), cA + kstep, voffA); PG8_STAGE(PG8_SB(1, 1), cB + hstepB + kstep, voffB);
    PG8_WAIT_V(6); PG8_BAR;
    for (;;) {
        const bool has_next = S.next(ui + 1, nxt);
        const char* nA = has_next ? (const char*)g.A + (size_t)nxt.pm * tstepA : cA; const char* nB = has_next ? (const char*)g.Bt + (size_t)nxt.pn * tstepB : cB;
        for (int t = 0; t < nt; t += 2) {
            const bool last = (t == nt - 2);
            const char* a1 = cA + (size_t)(t + 1) * kstep;
            const char* a2 = last ? nA : cA + (size_t)(t + 2) * kstep; const char* b2 = last ? nB : cB + (size_t)(t + 2) * kstep;
            const char* a3 = a2 + kstep; const char* b3 = b2 + kstep;
            if (last && has_next) S.a_ready(nxt);
            PG8_LDB(B0, 0, 0); PG8_SCHED; PG8_LDA(At, 0, 0); PG8_STAGE(PG8_SA(1, 1), a1 + hstepA, voffA);
            PG8_WAIT_L(8); PG8_BAR; PG8_WAIT_L(0); PG8_MMA(0, 0, At, B0); PG8_BAR; PG8_SCHED;
            PG8_LDB(B1, 0, 1); PG8_STAGE(PG8_SB(0, 0), b2, voffB);
            PG8_BAR; PG8_WAIT_L(0); PG8_MMA(0, 1, At, B1); PG8_BAR;
            PG8_LDA(At, 0, 1); PG8_STAGE(PG8_SA(0, 0), a2, voffA);
            PG8_BAR; PG8_WAIT_L(0); PG8_MMA(1, 0, At, B0); PG8_BAR; PG8_SCHED;
            PG8_STAGE(PG8_SB(0, 1), b2 + hstepB, voffB);
            PG8_WAIT_V(6); PG8_BAR; PG8_MMA(1, 1, At, B1); PG8_BAR;
            PG8_LDB(B0, 1, 0); PG8_SCHED; PG8_LDA(At, 1, 0); PG8_STAGE(PG8_SA(0, 1), a2 + hstepA, voffA);
            PG8_WAIT_L(8); PG8_BAR; PG8_WAIT_L(0); PG8_MMA(0, 0, At, B0); PG8_BAR; PG8_SCHED;
            PG8_LDB(B1, 1, 1); PG8_STAGE(PG8_SB(1, 0), b3, voffB);
            PG8_BAR; PG8_WAIT_L(0); PG8_MMA(0, 1, At, B1); PG8_BAR;
            PG8_LDA(At, 1, 1); PG8_STAGE(PG8_SA(1, 0), a3, voffA);
            PG8_BAR; PG8_WAIT_L(0); PG8_MMA(1, 0, At, B0); PG8_BAR; PG8_SCHED;
            PG8_STAGE(PG8_SB(1, 1), b3 + hstepB, voffB);
            PG8_WAIT_V(6); PG8_BAR; PG8_MMA(1, 1, At, B1); PG8_BAR;
        }
        E(acc, cur, wr, wc, fr, fq); S.done(cur);
        if (!has_next) break;
#pragma unroll
        for (int a = 0; a < 2; ++a)
#pragma unroll
            for (int b = 0; b < 2; ++b)
#pragma unroll
                for (int m = 0; m < 4; ++m)
#pragma unroll
                    for (int n = 0; n < 2; ++n) acc[a][b][m][n] = (f32x4){0.f, 0.f, 0.f, 0.f};
        cur = nxt; cA = nA; cB = nB; ++ui;
    }
    PG8_WAIT_V(0);
    if (wr == 0) PG8_BAR;
    PG8_BAR;
#undef PG8_SA
#undef PG8_SB
#undef PG8_STAGE
#undef PG8_LDA
#undef PG8_LDB
#undef PG8_MMA
#undef PG8_WAIT_V
#undef PG8_WAIT_L
#undef PG8_BAR
#undef PG8_SCHED
}
}
using pg8::Unit;

struct EpiIn {
    static constexpr bool PERM = true;
    bf16_t* qkvr; bf16_t* gr; bf16_t* gates;
    __device__ __forceinline__ void operator()(const f32x4 (&acc)[2][2][4][2], const Unit& u, int wr, int wc, int fr, int fq) const {
        const int row0 = (u.pm >> 6) * TB + (u.pm & 63) * 256 + wr * 64 + fr; const int pn = u.pn;
        bf16_t* base; int ld, colt, act;
        if (pn < 34) { base = qkvr; ld = QKVR_LD; colt = pn * 256; act = 0; }
        else if (pn < 42) { base = gr; ld = 2048; colt = (pn - 34) * 256; act = 1; }
        else { base = gates; ld = 2048; colt = (pn - 42) * 256; act = 2; }
        const int col0 = colt + wc * 32 + 8 * fq;
#pragma unroll
        for (int ai = 0; ai < 2; ++ai)
#pragma unroll
            for (int m = 0; m < 4; ++m) {
                const int row = row0 + ai * 128 + m * 16; float rs = 1.0f;
                if (pn >= 22 && pn < 26) rs = exp2f(log2f(1.0f - exp2f(-5.0f - (float)(pn - 22))) * (float)(127 - (row & 127)));
                bf16_t* rowp = base + (size_t)row * ld + col0;
#pragma unroll
                for (int bj = 0; bj < 2; ++bj) {
                    f32x4 v0 = acc[ai][bj][m][0] * rs, v1 = acc[ai][bj][m][1] * rs;
                    if (act == 1) {
#pragma unroll
                        for (int j = 0; j < 4; ++j) { v0[j] = v0[j] * sigmoidf_(v0[j]); v1[j] = v1[j] * sigmoidf_(v1[j]); }
                    } else if (act == 2) {
#pragma unroll
                        for (int j = 0; j < 4; ++j) { v0[j] = sigmoidf_(v0[j]); v1[j] = sigmoidf_(v1[j]); }
                    }
                    u32x4 w; w.x = cvt_pk_bf16(v0[0], v0[1]); w.y = cvt_pk_bf16(v0[2], v0[3]); w.z = cvt_pk_bf16(v1[0], v1[1]); w.w = cvt_pk_bf16(v1[2], v1[3]);
                    *(u32x4*)(rowp + bj * 128) = w;
                }
            }
    }
};
template <int SECOND> struct EpiGate {
    static constexpr bool PERM = true;
    const bf16_t* gates; bf16_t* Y;
    __device__ __forceinline__ void operator()(const f32x4 (&acc)[2][2][4][2], const Unit& u, int wr, int wc, int fr, int fq) const {
        const int row0 = u.pm * 256 + wr * 64 + fr; const int col0 = u.pn * 256 + wc * 32 + 8 * fq;
#pragma unroll
        for (int ai = 0; ai < 2; ++ai) {
            u32x4 gv[4][2], yv[4][2];
#pragma unroll
            for (int m = 0; m < 4; ++m)
#pragma unroll
                for (int bj = 0; bj < 2; ++bj) {
                    const int row = row0 + ai * 128 + m * 16, col = col0 + bj * 128;
                    gv[m][bj] = *(const u32x4*)(gates + (size_t)row * 2048 + SECOND * 1024 + col);
                    if (SECOND) yv[m][bj] = *(const u32x4*)(Y + (size_t)row * 1024 + col);
                }
#pragma unroll
            for (int m = 0; m < 4; ++m)
#pragma unroll
                for (int bj = 0; bj < 2; ++bj) {
                    const int row = row0 + ai * 128 + m * 16, col = col0 + bj * 128;
                    const u32x4 g = gv[m][bj];
                    const f32x4 a0 = acc[ai][bj][m][0], a1 = acc[ai][bj][m][1];
                    float r[8] = {a0[0] * bflo(g.x), a0[1] * bfhi(g.x), a0[2] * bflo(g.y), a0[3] * bfhi(g.y), a1[0] * bflo(g.z), a1[1] * bfhi(g.z), a1[2] * bflo(g.w), a1[3] * bfhi(g.w)};
                    if (SECOND) { const u32x4 y = yv[m][bj];
                        r[0] += bflo(y.x); r[1] += bfhi(y.x); r[2] += bflo(y.y); r[3] += bfhi(y.y); r[4] += bflo(y.z); r[5] += bfhi(y.z); r[6] += bflo(y.w); r[7] += bfhi(y.w); }
                    u32x4 w; w.x = cvt_pk_bf16(r[0], r[1]); w.y = cvt_pk_bf16(r[2], r[3]); w.z = cvt_pk_bf16(r[4], r[5]); w.w = cvt_pk_bf16(r[6], r[7]);
                    *(u32x4*)(Y + (size_t)row * 1024 + col) = w;
                }
        }
    }
};
struct EpiOut {
    static constexpr bool PERM = true;
    const float* x; bf16_t* x1b; float* ss2;
    __device__ __forceinline__ void operator()(const f32x4 (&acc)[2][2][4][2], const Unit& u, int wr, int wc, int fr, int fq) const {
        const int row0 = u.pm * 256 + wr * 64 + fr; const int col0 = u.pn * 256 + wc * 32 + 8 * fq;
#pragma unroll
        for (int ai = 0; ai < 2; ++ai) {
            f32x4 xv[4][2][2];
#pragma unroll
            for (int m = 0; m < 4; ++m)
#pragma unroll
                for (int bj = 0; bj < 2; ++bj) {
                    const size_t o = (size_t)(row0 + ai * 128 + m * 16) * 1024 + col0 + bj * 128;
                    xv[m][bj][0] = *(const f32x4*)(x + o); xv[m][bj][1] = *(const f32x4*)(x + o + 4);
                }
#pragma unroll
            for (int m = 0; m < 4; ++m) {
                const int row = row0 + ai * 128 + m * 16; float ss = 0.f;
#pragma unroll
                for (int bj = 0; bj < 2; ++bj) {
                    const size_t o = (size_t)row * 1024 + col0 + bj * 128;
                    const f32x4 v0 = xv[m][bj][0] + acc[ai][bj][m][0], v1 = xv[m][bj][1] + acc[ai][bj][m][1];
                    ss += (v0[0] * v0[0] + v0[1] * v0[1]) + (v0[2] * v0[2] + v0[3] * v0[3]) + (v1[0] * v1[0] + v1[1] * v1[1]) + (v1[2] * v1[2] + v1[3] * v1[3]);
                    u32x4 w; w.x = cvt_pk_bf16(v0[0], v0[1]); w.y = cvt_pk_bf16(v0[2], v0[3]); w.z = cvt_pk_bf16(v1[0], v1[1]); w.w = cvt_pk_bf16(v1[2], v1[3]);
                    *(u32x4*)(x1b + o) = w;
                }
                ss += shx(ss, fq * 16 + fr, 16); ss += shx(ss, fq * 16 + fr, 32);
                ss2[(size_t)row * 16 + u.pn * 4 + wc] = ss;
            }
        }
    }
};
struct EpiUp {
    static constexpr bool PERM = true;
    const float* ss2; bf16_t* H;
    __device__ __forceinline__ void operator()(const f32x4 (&acc)[2][2][4][2], const Unit& u, int wr, int wc, int fr, int fq) const {
        const int row0 = u.pm * 256 + wr * 64 + fr; const int col0 = u.pn * 256 + wc * 32 + 8 * fq;
        f32x4 sq[2][4];
#pragma unroll
        for (int ai = 0; ai < 2; ++ai)
#pragma unroll
            for (int m = 0; m < 4; ++m) sq[ai][m] = *(const f32x4*)(ss2 + (size_t)(row0 + ai * 128 + m * 16) * 16 + 4 * fq);
#pragma unroll
        for (int ai = 0; ai < 2; ++ai)
#pragma unroll
            for (int m = 0; m < 4; ++m) {
                const int row = row0 + ai * 128 + m * 16;
                float ss = (sq[ai][m][0] + sq[ai][m][1]) + (sq[ai][m][2] + sq[ai][m][3]);
                ss += shx(ss, fq * 16 + fr, 16); ss += shx(ss, fq * 16 + fr, 32);
                const float rs = rsqrtf(ss * (1.0f / 1024.0f) + EPS);
#pragma unroll
                for (int bj = 0; bj < 2; ++bj) {
                    f32x4 v0 = acc[ai][bj][m][0] * rs, v1 = acc[ai][bj][m][1] * rs;
#pragma unroll
                    for (int j = 0; j < 4; ++j) { const float a = fmaxf(v0[j], 0.f), b = fmaxf(v1[j], 0.f); v0[j] = a * a; v1[j] = b * b; }
                    u32x4 w; w.x = cvt_pk_bf16(v0[0], v0[1]); w.y = cvt_pk_bf16(v0[2], v0[3]); w.z = cvt_pk_bf16(v1[0], v1[1]); w.w = cvt_pk_bf16(v1[2], v1[3]);
                    *(u32x4*)(H + (size_t)row * DFF + col0 + bj * 128) = w;
                }
            }
    }
};
struct EpiDown {
    static constexpr bool PERM = false;
    const bf16_t* x1b; float* out;
    __device__ __forceinline__ void operator()(const f32x4 (&acc)[2][2][4][2], const Unit& u, int wr, int wc, int fr, int fq) const {
        const int row0 = u.pm * 256 + wr * 64 + fr; const int col0 = u.pn * 256 + wc * 32 + 4 * fq;
        u32x2 xv[2][4][2][2];
#pragma unroll
        for (int ai = 0; ai < 2; ++ai)
#pragma unroll
            for (int m = 0; m < 4; ++m)
#pragma unroll
                for (int bj = 0; bj < 2; ++bj)
#pragma unroll
                    for (int n = 0; n < 2; ++n) xv[ai][m][bj][n] = *(const u32x2*)(x1b + (size_t)(row0 + ai * 128 + m * 16) * 1024 + col0 + bj * 128 + n * 16);
#pragma unroll
        for (int ai = 0; ai < 2; ++ai)
#pragma unroll
            for (int m = 0; m < 4; ++m)
#pragma unroll
                for (int bj = 0; bj < 2; ++bj)
#pragma unroll
                    for (int n = 0; n < 2; ++n) {
                        const size_t o = (size_t)(row0 + ai * 128 + m * 16) * 1024 + col0 + bj * 128 + n * 16;
                        const u32x2 v = xv[ai][m][bj][n]; const f32x4 a = acc[ai][bj][m][n];
                        *(f32x4*)(out + o) = (f32x4){bflo(v.x) + a[0], bfhi(v.x) + a[1], bflo(v.y) + a[2], bfhi(v.y) + a[3]};
                    }
    }
};

struct InProjOrder {
    pg8::StaticOrder so; int G, c, b, gstart, ng;
    __device__ void init(int b_, int G_, int c_) { so.init(TB, 42 * 256, G_, c_); G = G_; c = c_; b = b_; gstart = b_ == 0 ? 0 : 256 + 192 * b_; ng = b_ == 0 ? 448 : 192; }
    __device__ bool next(int i, Unit& u) const {
        const long L = (long)i * G + c;
        if (L < 1344) return so.next(i, u);
        const int gi = (int)L - 1344; if (gi >= ng) return false;
        const int gu = gstart + gi, bq = gu >> 8, wi = gu & 255;
        u.pm = (bq - b) * 64 + (wi >> 3); u.pn = 42 + (wi & 7); return true;
    }
    __device__ __forceinline__ void a_ready(const Unit&) const {}
    __device__ __forceinline__ void done(const Unit&) const {}
};

__device__ __forceinline__ void transpose_w(const int wv, LAS unsigned char* lds, const float* __restrict__ w, bf16_t* __restrict__ wt, int K, int N, const float* __restrict__ gk, int slo, int shi, float scale) {
    const int tk = K / 64, tn = N / 64, nt = tk * tn;
    const int t = TIDX, nl = t & 63, kg = t >> 6, n2 = t >> 3, kc = t & 7;
    for (int tile = blockIdx.x; tile < nt; tile += gridDim.x) {
        const int kt0 = (tile % tk) * 64, nb0 = (tile / tk) * 64;
        const int k0 = kt0 + kg * 8, n = nb0 + nl;
        float v[8];
#pragma unroll
        for (int j = 0; j < 8; ++j) { float g = gk ? gk[k0 + j] : 1.0f; v[j] = w[(size_t)(k0 + j) * N + n] * g; }
        if (n >= slo && n < shi) {
#pragma unroll
            for (int j = 0; j < 8; ++j) v[j] *= scale;
        }
        u32x4 o; o.x = cvt_pk_bf16(v[0], v[1]); o.y = cvt_pk_bf16(v[2], v[3]); o.z = cvt_pk_bf16(v[4], v[5]); o.w = cvt_pk_bf16(v[6], v[7]);
        *(LAS u32x4*)(lds + nl * 144 + kg * 16) = o;
        __syncthreads();
        *(u32x4*)(wt + (size_t)(nb0 + n2) * K + kt0 + kc * 8) = *(const LAS u32x4*)(lds + n2 * 144 + kc * 16);
        __syncthreads();
    }
}
__device__ __forceinline__ void prep_x(const int wv, const float* __restrict__ x, bf16_t* __restrict__ orbuf) {
    const int wave = TIDX >> 6, lane = TIDX & 63;
    const int rstride = gridDim.x * 8;
    for (int row0 = blockIdx.x * 8 + wave; row0 < MT; row0 += 4 * rstride) {
        f32x4 v[4][4];
#pragma unroll
        for (int q = 0; q < 4; ++q) { const int row = row0 + q * rstride;
            if (row < MT) {
#pragma unroll
                for (int i = 0; i < 4; ++i) v[q][i] = *(const f32x4*)(x + (size_t)row * DM + i * 256 + lane * 4);
            } }
#pragma unroll
        for (int q = 0; q < 4; ++q) { const int row = row0 + q * rstride;
            if (row < MT) {
                const int b = row / TB, r = row % TB;
                bf16_t* xo = orbuf + (size_t)b * TB * 2048 + (size_t)r * DM;
                float ss = 0.f;
#pragma unroll
                for (int i = 0; i < 4; ++i) ss += v[q][i][0] * v[q][i][0] + v[q][i][1] * v[q][i][1] + v[q][i][2] * v[q][i][2] + v[q][i][3] * v[q][i][3];
#pragma unroll
                for (int o = 1; o < 64; o <<= 1) ss += shx(ss, lane, o);
                const float rs = rsqrtf(ss * (1.0f / 1024.0f) + EPS);
#pragma unroll
                for (int i = 0; i < 4; ++i) { u32x2 w; w.x = cvt_pk_bf16(v[q][i][0] * rs, v[q][i][1] * rs); w.y = cvt_pk_bf16(v[q][i][2] * rs, v[q][i][3] * rs); *(u32x2*)(xo + i * 256 + lane * 4) = w; }
            } }
    }
}

__device__ __forceinline__ void attn_stream(const int wv, LAS unsigned char* lds, unsigned ldsb, const float* __restrict__ qng, const float* __restrict__ kng, const bf16_t* __restrict__ qkvr, bf16_t* __restrict__ og, float* __restrict__ lse,
                                            int first, int stride, int count) {
    int t_ = TIDX; asm volatile("" : "+v"(t_));
    const int t = t_, w = __builtin_amdgcn_readfirstlane(t >> 6), lane = t & 63, li = lane & 15, g = lane >> 4;
    if (first >= count) return;
    const unsigned QI = 0, KI = 128 * PA;
    const int c16 = t & 15, c160 = t & 15, rr0 = t >> 4, rr = t >> 4;
    u32x4 qr[4], kr[8], vr[8];
#define ATTN_GEOM(item_) const int hh = (item_) >> 6, blk = (item_) & 63; const int grp = hh >> 2, dil = grp == 0 ? 1 : (grp == 1 ? 4 : 16), nb = 64 / dil; const int r = blk / nb, n = blk % nb;
#define ATTN_LOAD_QK(item_) do { ATTN_GEOM(item_) int rr = rr0; asm volatile("" : "+v"(rr)); int c16 = c160; asm volatile("" : "+v"(c16)); \
        _Pragma("unroll") for (int it = 0; it < 4; ++it) { const int row = rr + 32 * it; qr[it] = *(const u32x4*)(qkvr + (size_t)((n * 128 + row) * dil + r) * QKVR_LD + C_AQ + hh * 128 + c16 * 8); } \
        _Pragma("unroll") for (int it = 0; it < 8; ++it) { const int l = n * 128 - 128 + rr + 32 * it; kr[it] = (u32x4){0u, 0u, 0u, 0u}; \
            if (l >= 0) kr[it] = *(const u32x4*)(qkvr + (size_t)(l * dil + r) * QKVR_LD + C_AK + hh * 128 + c16 * 8); } } while (0)
    int item = first;
    ATTN_LOAD_QK(item);
    for (;;) {
        ATTN_GEOM(item)
        const int inext = item + stride;
        {
            float gq[8], gk[8];
            int c8 = c16 * 8; asm volatile("" : "+v"(c8));
#pragma unroll
            for (int j = 0; j < 8; ++j) { gq[j] = qng[hh * 128 + c8 + j] * 0.08838834764831845f; gk[j] = kng[hh * 128 + c8 + j]; }
#pragma unroll
            for (int it = 0; it < 12; ++it) {
                const u32x4 v = it < 4 ? qr[it] : kr[it - 4];
                float f[8] = {bflo(v.x), bfhi(v.x), bflo(v.y), bfhi(v.y), bflo(v.z), bfhi(v.z), bflo(v.w), bfhi(v.w)};
                float ss = 0.f;
#pragma unroll
                for (int j = 0; j < 8; ++j) ss += f[j] * f[j];
                ss += shx(ss, lane, 1); ss += shx(ss, lane, 2); ss += shx(ss, lane, 4); ss += shx(ss, lane, 8);
                const float rs = rsqrtf(ss * (1.0f / 128.0f) + EPS);
#pragma unroll
                for (int j = 0; j < 8; ++j) f[j] *= rs * (it < 4 ? gq[j] : gk[j]);
                u32x4 o; o.x = cvt_pk_bf16(f[0], f[1]); o.y = cvt_pk_bf16(f[2], f[3]); o.z = cvt_pk_bf16(f[4], f[5]); o.w = cvt_pk_bf16(f[6], f[7]);
                if (it < 4) *(LAS u32x4*)(lds + QI + (rr + 32 * it) * PA + c16 * 16) = o;
                else *(LAS u32x4*)(lds + KI + (rr + 32 * (it - 4)) * PA + c16 * 16) = o;
            }
        }
        __syncthreads();
#pragma unroll
        for (int it = 0; it < 8; ++it) { const int l = n * 128 - 128 + rr + 32 * it; vr[it] = (u32x4){0u, 0u, 0u, 0u};
            if (l >= 0) vr[it] = *(const u32x4*)(qkvr + (size_t)(l * dil + r) * QKVR_LD + C_AV + hh * 128 + c16 * 8); }
        bf16x8 qf[4];
#pragma unroll
        for (int s2 = 0; s2 < 4; ++s2) qf[s2] = *(const LAS bf16x8*)(lds + QI + (16 * w + li) * PA + (32 * s2 + 8 * g) * 2);
        f32x4 sc[10];
#pragma unroll
        for (int t3 = 0; t3 < 9; t3 += 3) {
            bf16x8 kf[3][4];
#pragma unroll
            for (int q = 0; q < 3; ++q)
#pragma unroll
                for (int s2 = 0; s2 < 4; ++s2) kf[q][s2] = *(const LAS bf16x8*)(lds + KI + (16 * (w + t3 + q) + li) * PA + (32 * s2 + 8 * g) * 2);
            asm volatile("s_waitcnt lgkmcnt(0)" ::: "memory");
            f32x4 a0 = (f32x4){0.f, 0.f, 0.f, 0.f}, a1 = a0, a2 = a0;
#pragma unroll
            for (int s2 = 0; s2 < 4; ++s2) { a0 = MFMA16(kf[0][s2], qf[s2], a0); a1 = MFMA16(kf[1][s2], qf[s2], a1); a2 = MFMA16(kf[2][s2], qf[s2], a2); }
            sc[t3] = a0; sc[t3 + 1] = a1; sc[t3 + 2] = a2;
        }
        sc[9] = (f32x4){0.f, 0.f, 0.f, 0.f};
        const float slope = exp2f(-8.0f * (float)(hh + 1) / 12.0f) * (float)dil;
        const int qi = 16 * w + li;
        float mx = -3.0e38f;
#pragma unroll
        for (int tt = 0; tt < 9; ++tt)
#pragma unroll
            for (int e = 0; e < 4; ++e) {
                const int kj = 16 * (w + tt) + 4 * g + e; const int dist = 128 + qi - kj;
                const bool valid = (dist >= 0) && (dist <= 128) && (n > 0 || kj >= 128);
                const float sv = valid ? sc[tt][e] - slope * (float)dist : -3.0e38f;
                sc[tt][e] = sv; mx = fmaxf(mx, sv);
            }
        mx = fmaxf(mx, shx(mx, lane, 16)); mx = fmaxf(mx, shx(mx, lane, 32));
        float den = 0.f;
#pragma unroll
        for (int tt = 0; tt < 9; ++tt)
#pragma unroll
            for (int e = 0; e < 4; ++e) { const float sv = sc[tt][e]; const float pv = (sv > -1.0e38f) ? __expf(sv - mx) : 0.f; sc[tt][e] = pv; den += pv; }
        den += shx(den, lane, 16); den += shx(den, lane, 32);
        bf16x8 pf[5];
#pragma unroll
        for (int u = 0; u < 5; ++u) { Frag f; f.u.x = cvt_pk_bf16(sc[2 * u][0], sc[2 * u][1]); f.u.y = cvt_pk_bf16(sc[2 * u][2], sc[2 * u][3]); f.u.z = cvt_pk_bf16(sc[2 * u + 1][0], sc[2 * u + 1][1]); f.u.w = cvt_pk_bf16(sc[2 * u + 1][2], sc[2 * u + 1][3]); pf[u] = f.v; }
        __syncthreads();
#pragma unroll
        for (int it = 0; it < 8; ++it) *(LAS u32x4*)(lds + KI + (rr + 32 * it) * PA + c16 * 16) = vr[it];
        __syncthreads();
        if (inext < count) ATTN_LOAD_QK(inext);
        f32x4 oacc[8];
#pragma unroll
        for (int c = 0; c < 8; ++c) oacc[c] = (f32x4){0.f, 0.f, 0.f, 0.f};
        const int q4 = li >> 2, p4 = lane & 3;
#pragma unroll
        for (int u = 0; u < 5; ++u) {
            int kt0 = w + 2 * u, kt1 = w + 2 * u + 1; kt0 = kt0 > 15 ? 15 : kt0; kt1 = kt1 > 15 ? 15 : kt1;
            const unsigned a0 = ldsb + KI + (16 * kt0 + 4 * g + q4) * PA + 8 * p4;
            const unsigned a1 = ldsb + KI + (16 * kt1 + 4 * g + q4) * PA + 8 * p4;
#pragma unroll
            for (int c = 0; c < 8; c += 4) {
                bf16x8 v0, v1, v2, v3;
                tr_frag4(a0, a1, 32u * c, 32u * (c + 1), 32u * (c + 2), 32u * (c + 3), v0, v1, v2, v3);
                oacc[c] = MFMA16(pf[u], v0, oacc[c]); oacc[c + 1] = MFMA16(pf[u], v1, oacc[c + 1]);
                oacc[c + 2] = MFMA16(pf[u], v2, oacc[c + 2]); oacc[c + 3] = MFMA16(pf[u], v3, oacc[c + 3]);
            }
        }
        if (g == 0) lse[(size_t)((n * 128 + qi) * dil + r) * 12 + hh] = mx + __logf(den);
#pragma unroll
        for (int e = 0; e < 4; ++e) {
            const float inv = 1.0f / shl(den, 4 * g + e);
#pragma unroll
            for (int c = 0; c < 8; ++c) *(LAS bf16_t*)(lds + QI + (16 * w + 4 * g + e) * PA + (16 * c + li) * 2) = f2bf(oacc[c][e] * inv);
        }
        __syncthreads();
#pragma unroll
        for (int k = 0; k < 4; ++k) {
            const int id = t + 512 * k, row = id >> 4, ch = id & 15;
            *(u32x4*)(og + (size_t)((n * 128 + row) * dil + r) * 1536 + hh * 128 + ch * 8) = *(const LAS u32x4*)(lds + QI + row * PA + ch * 16);
        }
        __syncthreads();
        if (inext >= count) break;
        item = inext;
    }
#undef ATTN_GEOM
#undef ATTN_LOAD_QK
}

__device__ __forceinline__ unsigned sw512(unsigned row, unsigned chunk) { return row * 512u + ((chunk ^ (row & 15u)) << 4); }
#define DMA16(gp, lp) __builtin_amdgcn_global_load_lds((const unsigned*)(gp), (LAS unsigned*)(lp), 16, 0, 0)
#define WAITV0() asm volatile("s_waitcnt vmcnt(0)" ::: "memory")
#define LBAR() do { asm volatile("s_waitcnt lgkmcnt(0)" ::: "memory"); __builtin_amdgcn_s_barrier(); asm volatile("" ::: "memory"); } while (0)
__device__ __forceinline__ void tr_frag4x(unsigned x0, unsigned y0, unsigned x1, unsigned y1, unsigned x2, unsigned y2, unsigned x3, unsigned y3, bf16x8& f0, bf16x8& f1, bf16x8& f2, bf16x8& f3) {
    u32x2 r0, r1, r2, r3, r4, r5, r6, r7;
    asm volatile("ds_read_b64_tr_b16 %0, %8\n\tds_read_b64_tr_b16 %1, %9\n\tds_read_b64_tr_b16 %2, %10\n\tds_read_b64_tr_b16 %3, %11\n\t"
                 "ds_read_b64_tr_b16 %4, %12\n\tds_read_b64_tr_b16 %5, %13\n\tds_read_b64_tr_b16 %6, %14\n\tds_read_b64_tr_b16 %7, %15\n\ts_waitcnt lgkmcnt(0)"
                 : "=&v"(r0), "=&v"(r1), "=&v"(r2), "=&v"(r3), "=&v"(r4), "=&v"(r5), "=&v"(r6), "=&v"(r7)
                 : "v"(x0), "v"(y0), "v"(x1), "v"(y1), "v"(x2), "v"(y2), "v"(x3), "v"(y3) : "memory");
    Frag f; f.u = (u32x4){r0.x, r0.y, r1.x, r1.y}; f0 = f.v; f.u = (u32x4){r2.x, r2.y, r3.x, r3.y}; f1 = f.v;
    f.u = (u32x4){r4.x, r4.y, r5.x, r5.y}; f2 = f.v; f.u = (u32x4){r6.x, r6.y, r7.x, r7.y}; f3 = f.v;
}

__device__ __forceinline__ void ret_scan(const int wv, bf16_t* __restrict__ kv) {
    int ts_ = TIDX; asm volatile("" : "+v"(ts_));
    for (int idx = blockIdx.x * 512 + ts_; idx < 4 * 32768; idx += gridDim.x * 512) {
        const int h = idx >> 15, e4 = idx & 32767;
        const float gC = exp2f(128.0f * log2f(1.0f - exp2f(-5.0f - (float)h)));
        bf16_t* pbase = kv + (size_t)h * 64 * 131072 + (size_t)e4 * 4;
        float s0 = 0.f, s1 = 0.f, s2 = 0.f, s3 = 0.f;
#pragma unroll 1
        for (int n0 = 0; n0 < 64; n0 += 8) {
            u32x2 v[8];
#pragma unroll
            for (int k = 0; k < 8; ++k) v[k] = *(const u32x2*)(pbase + (size_t)(n0 + k) * 131072);
#pragma unroll
            for (int k = 0; k < 8; ++k) {
                u32x2 o; o.x = cvt_pk_bf16(s0, s1); o.y = cvt_pk_bf16(s2, s3);
                *(u32x2*)(pbase + (size_t)(n0 + k) * 131072) = o;
                s0 = (s0 + bflo(v[k].x)) * gC; s1 = (s1 + bfhi(v[k].x)) * gC; s2 = (s2 + bflo(v[k].y)) * gC; s3 = (s3 + bfhi(v[k].y)) * gC;
            }
        }
    }
}

__device__ __forceinline__ void retc_stream(const int wv, LAS unsigned char* lds, unsigned ldsb, const float* __restrict__ gn_g, const float* __restrict__ gn_b, const bf16_t* __restrict__ qkvr, const bf16_t* __restrict__ grb, const bf16_t* __restrict__ kv,
                                            bf16_t* __restrict__ orb  , int first, int stride, int count) {
    int t_ = TIDX; asm volatile("" : "+v"(t_));
    const int t = t_, w = __builtin_amdgcn_readfirstlane(t >> 6), lane = t & 63, li = lane & 15, g = lane >> 4;
    if (first >= count) return;
    const size_t RS = (size_t)QKVR_LD * 2;
    const unsigned rsub = (unsigned)w * 2u + ((unsigned)lane >> 5), cc = ((unsigned)lane & 31u) ^ rsub;
    const size_t goffA = (size_t)rsub * RS + cc * 16;
    const size_t goffS = (size_t)rsub * 512 + cc * 16;
    const int q4 = li >> 2, p4 = lane & 3;
#define RETC_ISSUE(item_, s_) do { const int h_ = (item_) >> 6, n_ = (item_) & 63; const unsigned img_ = ((s_) & 1) * 65536u; \
        if ((s_) < 4) { const int col_ = (s_) == 0 ? C_RQ + h_ * 256 : ((s_) == 1 ? C_RK + h_ * 256 : C_RV + h_ * 512 + ((s_) - 2) * 256); \
            const char* gb_ = (const char*)(qkvr + (size_t)(n_ * 128) * QKVR_LD + col_) + goffA; \
            _Pragma("unroll") for (int i_ = 0; i_ < 8; ++i_) DMA16(gb_ + (size_t)i_ * 16 * RS, lds + img_ + i_ * 8192 + w * 1024); } \
        else { const char* gb_ = (const char*)(kv + ((size_t)(h_ * 64 + n_) * 512 + ((s_) - 4) * 128) * 256) + goffS; \
            _Pragma("unroll") for (int i_ = 0; i_ < 8; ++i_) DMA16(gb_ + (size_t)i_ * 16 * 512, lds + img_ + i_ * 8192 + w * 1024); } } while (0)
    unsigned koff[8], toff[8];
#pragma unroll
    for (int s = 0; s < 8; ++s) { koff[s] = (unsigned)li * 512u + ((((unsigned)(4 * s + g)) ^ (unsigned)li) << 4); asm volatile("" : "+v"(koff[s])); }
    { const unsigned xx = (unsigned)(4 * g + q4) & 15u, ph = (unsigned)p4 >> 1, rb = (unsigned)(4 * g + q4) * 512u + 8u * ((unsigned)p4 & 1u);
#pragma unroll
      for (int c = 0; c < 8; ++c) { toff[c] = rb + (((2u * c + ph) ^ xx) << 4); asm volatile("" : "+v"(toff[c])); } }
    int item = first;
    RETC_ISSUE(item, 0);
    for (;;) {
        const int h = item >> 6, n = item & 63;
        const int inext = item + stride;
        const float lg2 = log2f(1.0f - exp2f(-5.0f - (float)h));
        WAITV0(); LBAR(); RETC_ISSUE(item, 1);
        bf16x8 qf[8];
        { unsigned ib = (unsigned)w * 8192u; asm volatile("" : "+v"(ib));
#pragma unroll
        for (int s = 0; s < 8; ++s) qf[s] = *(const LAS bf16x8*)(lds + ib + koff[s]); }
        WAITV0(); LBAR(); RETC_ISSUE(item, 2);
        bf16x8 pf[4];
        {
            f32x4 sc[8];
            const int qi = 16 * w + li;
            unsigned ibk = 65536u; asm volatile("" : "+v"(ibk));
#pragma unroll
            for (int kt = 0; kt < 8; ++kt) {
                f32x4 a = (f32x4){0.f, 0.f, 0.f, 0.f};
                if (kt <= w) {
                    bf16x8 kf[8];
#pragma unroll
                    for (int s = 0; s < 8; ++s) kf[s] = *(const LAS bf16x8*)(lds + ibk + kt * 8192 + koff[s]);
                    asm volatile("s_waitcnt lgkmcnt(0)" ::: "memory");
#pragma unroll
                    for (int s = 0; s < 8; ++s) a = MFMA16(kf[s], qf[s], a);
                }
#pragma unroll
                for (int e = 0; e < 4; ++e) { const int kj = 16 * kt + 4 * g + e; a[e] = (kj <= qi) ? a[e] : 0.f; }
                sc[kt] = a;
            }
#pragma unroll
            for (int u = 0; u < 4; ++u) { Frag f; f.u.x = cvt_pk_bf16(sc[2 * u][0], sc[2 * u][1]); f.u.y = cvt_pk_bf16(sc[2 * u][2], sc[2 * u][3]); f.u.z = cvt_pk_bf16(sc[2 * u + 1][0], sc[2 * u + 1][1]); f.u.w = cvt_pk_bf16(sc[2 * u + 1][2], sc[2 * u + 1][3]); pf[u] = f.v; }
        }
        f32x4 acc[32];
#pragma unroll
        for (int c = 0; c < 32; ++c) acc[c] = (f32x4){0.f, 0.f, 0.f, 0.f};
#pragma unroll
        for (int vh = 0; vh < 2; ++vh) {
            WAITV0(); LBAR(); RETC_ISSUE(item, 3 + vh);
            unsigned imgb = ldsb + vh * 65536u; asm volatile("" : "+v"(imgb));
#pragma unroll
            for (int u = 0; u < 4; ++u) {
                if (2 * u <= w) {
                    const unsigned a0 = imgb + u * 16384u, a1 = a0 + 8192u;
#pragma unroll
                    for (int c = 0; c < 16; c += 4) {
                        bf16x8 v0, v1, v2, v3;
                        const unsigned hi = (c >> 3) * 256u;
                        tr_frag4x(a0 + hi + toff[c & 7], a1 + hi + toff[c & 7], a0 + hi + toff[(c & 7) + 1], a1 + hi + toff[(c & 7) + 1],
                                  a0 + hi + toff[(c & 7) + 2], a1 + hi + toff[(c & 7) + 2], a0 + hi + toff[(c & 7) + 3], a1 + hi + toff[(c & 7) + 3], v0, v1, v2, v3);
                        acc[vh * 16 + c] = MFMA16(pf[u], v0, acc[vh * 16 + c]); acc[vh * 16 + c + 1] = MFMA16(pf[u], v1, acc[vh * 16 + c + 1]);
                        acc[vh * 16 + c + 2] = MFMA16(pf[u], v2, acc[vh * 16 + c + 2]); acc[vh * 16 + c + 3] = MFMA16(pf[u], v3, acc[vh * 16 + c + 3]);
                    }
                }
            }
        }
#pragma unroll
        for (int vc = 0; vc < 4; ++vc) {
            WAITV0(); LBAR();
            if (vc < 3) RETC_ISSUE(item, 5 + vc);
            unsigned img = (vc & 1) * 65536u; asm volatile("" : "+v"(img));
#pragma unroll
            for (int s = 0; s < 8; ++s) {
                bf16x8 bfr[8];
#pragma unroll
                for (int c = 0; c < 8; ++c) bfr[c] = *(const LAS bf16x8*)(lds + img + c * 8192 + koff[s]);
                asm volatile("s_waitcnt lgkmcnt(0)" ::: "memory");
#pragma unroll
                for (int c = 0; c < 8; ++c) acc[vc * 8 + c] = MFMA16(qf[s], bfr[c], acc[vc * 8 + c]);
            }
        }
        const float* gng = gn_g + h * 512; const float* gnb = gn_b + h * 512;
        float mu4[4], rs4[4];
#pragma unroll
        for (int e = 0; e < 4; ++e) {
            const int q = 16 * w + 4 * g + e;
            const float xi = exp2f(lg2 * (float)(q - 127));
            float sum = 0.f;
#pragma unroll
            for (int c = 0; c < 32; ++c) { acc[c][e] *= xi; sum += acc[c][e]; }
            sum += shx(sum, lane, 1); sum += shx(sum, lane, 2); sum += shx(sum, lane, 4); sum += shx(sum, lane, 8);
            const float mu = sum * (1.0f / 512.0f);
            float var = 0.f;
#pragma unroll
            for (int c = 0; c < 32; ++c) { const float d = acc[c][e] - mu; var += d * d; }
            var += shx(var, lane, 1); var += shx(var, lane, 2); var += shx(var, lane, 4); var += shx(var, lane, 8);
            mu4[e] = mu; rs4[e] = rsqrtf(var * (1.0f / 512.0f) + EPS);
        }
        LBAR();
        {
            unsigned wb = (unsigned)(16 * w + 4 * g) * 1024u + (unsigned)li * 2u; asm volatile("" : "+v"(wb));
#pragma unroll
            for (int c = 0; c < 32; ++c) {
                const unsigned co = (unsigned)(((2 * c) ^ (2 * g)) * 16);
#pragma unroll
                for (int e = 0; e < 4; ++e)
                    *(LAS bf16_t*)(lds + wb + e * 1024 + co) = f2bf((acc[c][e] - mu4[e]) * rs4[e]);
            }
        }
        {
            int tq = t; asm volatile("" : "+v"(tq));
            const int ch = tq & 63, r0 = tq >> 6;
            const f32x4 g0 = *(const f32x4*)(gng + ch * 8), g1 = *(const f32x4*)(gng + ch * 8 + 4), b0 = *(const f32x4*)(gnb + ch * 8), b1 = *(const f32x4*)(gnb + ch * 8 + 4);
            u32x4 gv[16];
#pragma unroll
            for (int k = 0; k < 16; ++k) gv[k] = *(const u32x4*)(grb + (size_t)(n * 128 + r0 + 8 * k) * 2048 + h * 512 + ch * 8);
            LBAR();
#pragma unroll
            for (int k = 0; k < 16; ++k) {
                const int row = r0 + 8 * k;
                const u32x4 yv = *(const LAS u32x4*)(lds + row * 1024 + ((ch ^ (2 * ((row >> 2) & 3))) << 4));
                const u32x4 q = gv[k];
                u32x4 o;
                o.x = cvt_pk_bf16((bflo(yv.x) * g0[0] + b0[0]) * bflo(q.x), (bfhi(yv.x) * g0[1] + b0[1]) * bfhi(q.x));
                o.y = cvt_pk_bf16((bflo(yv.y) * g0[2] + b0[2]) * bflo(q.y), (bfhi(yv.y) * g0[3] + b0[3]) * bfhi(q.y));
                o.z = cvt_pk_bf16((bflo(yv.z) * g1[0] + b1[0]) * bflo(q.z), (bfhi(yv.z) * g1[1] + b1[1]) * bfhi(q.z));
                o.w = cvt_pk_bf16((bflo(yv.w) * g1[2] + b1[2]) * bflo(q.w), (bfhi(yv.w) * g1[3] + b1[3]) * bfhi(q.w));
                *(u32x4*)(orb + (size_t)(n * 128 + row) * 2048 + h * 512 + ch * 8) = o;
            }
        }
        if (inext >= count) break;
        LBAR();
        RETC_ISSUE(inext, 0);
        item = inext;
    }
#undef RETC_ISSUE
    WAITV0(); LBAR();
}

__device__ __forceinline__ void reta_item(const int wv, LAS unsigned char* lds, unsigned ldsb, const bf16_t* __restrict__ qkvr, bf16_t* __restrict__ kv, int j) {
    const int h = j >> 7, n = (j >> 1) & 63, vh = j & 1;
    int t_ = TIDX; asm volatile("" : "+v"(t_));
    const int t = t_, w = __builtin_amdgcn_readfirstlane(t >> 6), lane = t & 63, li = lane & 15, g = lane >> 4;
    const unsigned VI = 0, KI = 128 * PR;
    const float lg2 = log2f(1.0f - exp2f(-5.0f - (float)h));
    {
        const int c = t & 31, rr = t >> 5;
#pragma unroll
        for (int it = 0; it < 8; ++it) {
            const int row = rr + 16 * it; const size_t tokoff = (size_t)(n * 128 + row) * QKVR_LD;
            const u32x4 kvv = *(const u32x4*)(qkvr + tokoff + C_RK + h * 256 + c * 8);
            *(LAS u32x4*)(lds + KI + row * PR + c * 16) = kvv;
            const u32x4 v = *(const u32x4*)(qkvr + tokoff + C_RV + h * 512 + vh * 256 + c * 8);
            const float z = 1.0f;
            u32x4 o; o.x = cvt_pk_bf16(bflo(v.x) * z, bfhi(v.x) * z); o.y = cvt_pk_bf16(bflo(v.y) * z, bfhi(v.y) * z);
            o.z = cvt_pk_bf16(bflo(v.z) * z, bfhi(v.z) * z); o.w = cvt_pk_bf16(bflo(v.w) * z, bfhi(v.w) * z);
            *(LAS u32x4*)(lds + VI + row * PR + c * 16) = o;
        }
    }
    __syncthreads();
    const int wm = w >> 1, wn = w & 1;
    const int q4 = (lane & 15) >> 2, p4 = lane & 3;
    f32x4 acc[4][8];
#pragma unroll
    for (int mi = 0; mi < 4; ++mi)
#pragma unroll
        for (int ci = 0; ci < 8; ++ci) acc[mi][ci] = (f32x4){0.f, 0.f, 0.f, 0.f};
#pragma unroll 1
    for (int ks = 0; ks < 4; ++ks) {
        const unsigned r0 = (32 * ks + 8 * g + q4) * PR + 8 * p4, r1 = r0 + 4 * PR;
        bf16x8 af[4];
        tr_frag4(ldsb + KI + r0 + 128 * wm, ldsb + KI + r1 + 128 * wm, 0u, 32u, 64u, 96u, af[0], af[1], af[2], af[3]);
#pragma unroll
        for (int ci = 0; ci < 8; ci += 4) {
            bf16x8 b0, b1, b2, b3;
            tr_frag4(ldsb + VI + r0 + 256 * wn, ldsb + VI + r1 + 256 * wn, 32u * ci, 32u * (ci + 1), 32u * (ci + 2), 32u * (ci + 3), b0, b1, b2, b3);
#pragma unroll
            for (int mi = 0; mi < 4; ++mi) {
                acc[mi][ci] = MFMA16(af[mi], b0, acc[mi][ci]); acc[mi][ci + 1] = MFMA16(af[mi], b1, acc[mi][ci + 1]);
                acc[mi][ci + 2] = MFMA16(af[mi], b2, acc[mi][ci + 2]); acc[mi][ci + 3] = MFMA16(af[mi], b3, acc[mi][ci + 3]);
            }
        }
    }
    bf16_t* base = kv + ((size_t)(h * 64 + n) * 512 + vh * 256) * 256;
    __syncthreads();
#pragma unroll
    for (int mi = 0; mi < 4; ++mi)
#pragma unroll
        for (int ci = 0; ci < 8; ++ci) {
            u32x2 o; o.x = cvt_pk_bf16(acc[mi][ci][0], acc[mi][ci][1]); o.y = cvt_pk_bf16(acc[mi][ci][2], acc[mi][ci][3]);
            *(LAS u32x2*)(lds + (128 * wn + 16 * ci + li) * PR + (64 * wm + 16 * mi + 4 * g) * 2) = o;
        }
    __syncthreads();
#pragma unroll 4
    for (int k = 0; k < 16; ++k) {
        const int id = t + 512 * k, row = id >> 5, ch = id & 31;
        *(u32x4*)(base + (size_t)row * 256 + ch * 8) = *(const LAS u32x4*)(lds + row * PR + ch * 16);
    }
    __syncthreads();
}

__device__ __forceinline__ void attn_combine(const int wv, const bf16_t* __restrict__ og, const float* __restrict__ lse, bf16_t* __restrict__ oa  ) {
    int tc_ = TIDX; asm volatile("" : "+v"(tc_));
    const int stride = gridDim.x * 512;
    for (int idx0 = blockIdx.x * 512 + tc_; idx0 < TB * 64; idx0 += 4 * stride) {
        float l[4][3]; u32x4 v[4][3];
#pragma unroll
        for (int q = 0; q < 4; ++q) {
            const int idx = idx0 + q * stride;
            if (idx < TB * 64) {
                const int tok = idx >> 6, hs = (idx >> 4) & 3, c = idx & 15;
#pragma unroll
                for (int gi = 0; gi < 3; ++gi) { l[q][gi] = lse[tok * 12 + 4 * gi + hs]; v[q][gi] = *(const u32x4*)(og + (size_t)tok * 1536 + (4 * gi + hs) * 128 + c * 8); }
            }
        }
#pragma unroll
        for (int q = 0; q < 4; ++q) {
            const int idx = idx0 + q * stride;
            if (idx < TB * 64) {
                const int tok = idx >> 6, hs = (idx >> 4) & 3, c = idx & 15;
                const float m = fmaxf(l[q][0], fmaxf(l[q][1], l[q][2]));
                float a0 = __expf(l[q][0] - m), a1 = __expf(l[q][1] - m), a2 = __expf(l[q][2] - m);
                const float inv = __builtin_amdgcn_rcpf(a0 + a1 + a2); a0 *= inv; a1 *= inv; a2 *= inv;
                const u32x4 v0 = v[q][0], v1 = v[q][1], v2 = v[q][2];
                u32x4 o;
                o.x = cvt_pk_bf16(a0 * bflo(v0.x) + a1 * bflo(v1.x) + a2 * bflo(v2.x), a0 * bfhi(v0.x) + a1 * bfhi(v1.x) + a2 * bfhi(v2.x));
                o.y = cvt_pk_bf16(a0 * bflo(v0.y) + a1 * bflo(v1.y) + a2 * bflo(v2.y), a0 * bfhi(v0.y) + a1 * bfhi(v1.y) + a2 * bfhi(v2.y));
                o.z = cvt_pk_bf16(a0 * bflo(v0.z) + a1 * bflo(v1.z) + a2 * bflo(v2.z), a0 * bfhi(v0.z) + a1 * bfhi(v1.z) + a2 * bfhi(v2.z));
                o.w = cvt_pk_bf16(a0 * bflo(v0.w) + a1 * bflo(v1.w) + a2 * bflo(v2.w), a0 * bfhi(v0.w) + a1 * bfhi(v1.w) + a2 * bfhi(v2.w));
                *(u32x4*)(oa + (size_t)tok * 512 + hs * 128 + c * 8) = o;
            }
        }
    }
}


#define XB_TMO      128
#define XB_XCNT(j)  (256  + 64 * (j))
#define XB_XSUB(j)  (1280 + 64 * (j))
#define XB_XGEN(j)  (2304 + 64 * (j))
#define XB_TOP      3328
#define XB_TOPGEN   3392
#define XCD_BAR_WORDS 3456
#define XB_SPIN_CAP (1u << 22)
__device__ __forceinline__ unsigned xb_ld(unsigned* p)              { return __hip_atomic_load(p, __ATOMIC_RELAXED, __HIP_MEMORY_SCOPE_AGENT); }
__device__ __forceinline__ unsigned xb_add(unsigned* p, unsigned v) { return __hip_atomic_fetch_add(p, v, __ATOMIC_RELAXED, __HIP_MEMORY_SCOPE_AGENT); }
__device__ __forceinline__ unsigned xb_xcc_id() { return (unsigned)__builtin_amdgcn_s_getreg((3 << 11) | 20) & 0xFu; }
#define XB_SPIN(cond, bar) do { unsigned _sp = 0; while (cond) { __builtin_amdgcn_s_sleep(1); \
    if ((++_sp & 255u) == 0u) { if (xb_ld(&(bar)[XB_TMO])) break; if (_sp > XB_SPIN_CAP) { atomicAdd(&(bar)[XB_TMO], 1u); break; } } } } while (0)
struct XcdBarrier { unsigned* bar; unsigned x; volatile LAS unsigned* st; };
__device__ __forceinline__ XcdBarrier xcd_barrier_post(const int wv, unsigned* bar, volatile LAS unsigned* st) {
    XcdBarrier b; b.bar = bar; b.x = xb_xcc_id(); b.st = st;
    if (TIDX == 0) (void)xb_add(&bar[XB_XCNT(b.x)], 1u);
    return b;
}
__device__ __forceinline__ void xcd_barrier_complete(unsigned* bar, unsigned x, unsigned& nloc, unsigned& nx) {
    const unsigned G = gridDim.x * gridDim.y * gridDim.z;
    unsigned sum, cnt, mine, sp = 0u;
    for (;;) {
        sum = 0u; cnt = 0u; mine = 0u;
#pragma unroll
        for (unsigned j = 0; j < 16; ++j) { const unsigned c = xb_ld(&bar[XB_XCNT(j)]); sum += c; cnt += (c > 0u) ? 1u : 0u; mine = (j == x) ? c : mine; }
        if (sum == G) break;
        __builtin_amdgcn_s_sleep(1);
        if ((++sp & 255u) == 0u) { if (xb_ld(&bar[XB_TMO])) break; if (sp > XB_SPIN_CAP) { atomicAdd(&bar[XB_TMO], 1u); break; } }
    }
    nloc = mine > 0u ? mine : 1u; nx = cnt > 0u ? cnt : 1u;
}
__device__ __forceinline__ void xcd_barrier(const int wv, const XcdBarrier& b) {
    asm volatile("s_waitcnt vmcnt(0)" ::: "memory");
    __syncthreads();
    if (TIDX == 0) {
        unsigned long long barq = (unsigned long long)b.bar; asm volatile("" : "+s"(barq));
        unsigned* bar = (unsigned*)barq;
        __builtin_amdgcn_s_waitcnt(0);
        unsigned nloc = b.st[0], nx = b.st[1];
        if (nloc == 0u) { xcd_barrier_complete(bar, b.x, nloc, nx); b.st[0] = nloc; b.st[1] = nx; }
        const unsigned old = xb_add(&bar[XB_XSUB(b.x)], 1u);
        const unsigned gen = old / nloc;
        if (old + 1u == (gen + 1u) * nloc) {
            __builtin_amdgcn_fence(__ATOMIC_RELEASE, "agent");
            asm volatile("s_waitcnt vmcnt(0)" ::: "memory");
            const unsigned og = xb_add(&bar[XB_TOP], 1u);
            const unsigned tg = og / nx;
            if (og + 1u == (tg + 1u) * nx) xb_add(&bar[XB_TOPGEN], 1u);
            else XB_SPIN(xb_ld(&bar[XB_TOPGEN]) == tg, bar);
            __builtin_amdgcn_fence(__ATOMIC_ACQUIRE, "agent");
            xb_add(&bar[XB_XGEN(b.x)], 1u);
            asm volatile("s_waitcnt vmcnt(0)" ::: "memory");
        } else {
            XB_SPIN(xb_ld(&bar[XB_XGEN(b.x)]) == gen, bar);
            __builtin_amdgcn_fence(__ATOMIC_ACQUIRE, "agent");
            asm volatile("s_waitcnt vmcnt(0)" ::: "memory");
        }
    }
    __syncthreads();
}

typedef const __attribute__((address_space(4))) Params* KParams;
__device__ __forceinline__ KParams kparams() { unsigned long long a = (unsigned long long)__builtin_amdgcn_kernarg_segment_ptr(); asm volatile("" : "+s"(a)); return (KParams)a; }

__global__ void __launch_bounds__(512, 2) mega(Params p_unused) {
    extern __shared__ __attribute__((aligned(16))) unsigned char shm[];
    LAS unsigned char* lds = (LAS unsigned char*)shm;
    const unsigned ldsb = (unsigned)(size_t)lds;
    const int wv = __builtin_amdgcn_readfirstlane((int)(threadIdx.x >> 6));
    cg::grid_group grid = cg::this_grid();
    volatile LAS unsigned* xst = (volatile LAS unsigned*)(lds + LDS_BYTES - 16);
    if (TIDX == 0) { xst[0] = 0u; xst[1] = 0u; }
    __syncthreads();
    const XcdBarrier xb = xcd_barrier_post(wv, (unsigned*)(kparams()->ws + WS_BAR), xst);
#define GSYNC() xcd_barrier(wv, xb)
#define WSP(T, off) ((T*)(ws + (off)))

    {
        KParams kp = kparams(); unsigned char* ws = kp->ws;
        transpose_w(wv, lds, kp->w_in, WSP(bf16_t, WS_WIN), DM, INW, kp->norm1_g, C_RK, C_RK + 1024, 0.0625f);
        transpose_w(wv, lds, kp->w_pa, WSP(bf16_t, WS_WPA), 512, DM, nullptr, 0, 0, 1.f);
        transpose_w(wv, lds, kp->w_pb, WSP(bf16_t, WS_WPB), 2048, DM, nullptr, 0, 0, 1.f);
        transpose_w(wv, lds, kp->w_out, WSP(bf16_t, WS_WOUT), DM, DM, nullptr, 0, 0, 1.f);
        transpose_w(wv, lds, kp->w_up, WSP(bf16_t, WS_WUP), DM, DFF, kp->norm2_g, 0, 0, 1.f);
        transpose_w(wv, lds, kp->w_dn, WSP(bf16_t, WS_WDN), DFF, DM, nullptr, 0, 0, 1.f);
        prep_x(wv, kp->x, WSP(bf16_t, WS_OR));
    }
    if (kparams()->ws == nullptr) grid.sync();
    GSYNC();

    for (int b = 0; b < 4; ++b) {
        {
            KParams kp = kparams(); unsigned char* ws = kp->ws;
            pg8::Gemm gm{WSP(bf16_t, WS_OR) + (size_t)b * TB * 2048, WSP(bf16_t, WS_WIN), TB, INW, DM, DM, DM};
            InProjOrder S; S.init(b, (int)gridDim.x, (int)blockIdx.x);
            EpiIn E{WSP(bf16_t, WS_R0), WSP(bf16_t, WS_GR), (bf16_t*)kp->out + (size_t)b * TB * 2048};
            pg8::gemm_phase<EpiIn, InProjOrder>(wv, lds, gm, S, E);
        }
        GSYNC();
        {
            KParams kp = kparams(); unsigned char* ws = kp->ws;
            attn_stream(wv, lds, ldsb, kp->q_norm_g, kp->k_norm_g, WSP(bf16_t, WS_R0), WSP(bf16_t, WS_OG), WSP(float, WS_LSE), (int)blockIdx.x, (int)gridDim.x, 768);
        }
        {
            KParams kp = kparams(); unsigned char* ws = kp->ws;
            for (int j = blockIdx.x; j < 512; j += gridDim.x) reta_item(wv, lds, ldsb, WSP(bf16_t, WS_R0), WSP(bf16_t, WS_KV), j);
        }
        GSYNC();
        { KParams kp = kparams(); unsigned char* ws = kp->ws; ret_scan(wv, WSP(bf16_t, WS_KV)); }
        GSYNC();
        {
            KParams kp = kparams(); unsigned char* ws = kp->ws;
            retc_stream(wv, lds, ldsb, kp->gn_g, kp->gn_b, WSP(bf16_t, WS_R0), WSP(bf16_t, WS_GR), WSP(bf16_t, WS_KV), WSP(bf16_t, WS_OR) + (size_t)b * TB * 2048, (int)blockIdx.x, (int)gridDim.x, 256);
        }
        {
            KParams kp = kparams(); unsigned char* ws = kp->ws;
            attn_combine(wv, WSP(bf16_t, WS_OG), WSP(float, WS_LSE), WSP(bf16_t, WS_OA) + (size_t)b * TB * 512);
        }
        GSYNC();
    }
    {
        KParams kp = kparams(); unsigned char* ws = kp->ws;
        pg8::StaticOrder S; S.init(MT, DM, (int)gridDim.x, (int)blockIdx.x);
        { pg8::Gemm gm{WSP(bf16_t, WS_OA), WSP(bf16_t, WS_WPA), MT, DM, 512, 512, 512}; EpiGate<0> E{(const bf16_t*)kp->out, WSP(bf16_t, WS_Y)}; pg8::gemm_phase<EpiGate<0>, pg8::StaticOrder>(wv, lds, gm, S, E); }
        { pg8::Gemm gm{WSP(bf16_t, WS_OR), WSP(bf16_t, WS_WPB), MT, DM, 2048, 2048, 2048}; EpiGate<1> E{(const bf16_t*)kp->out, WSP(bf16_t, WS_Y)}; pg8::gemm_phase<EpiGate<1>, pg8::StaticOrder>(wv, lds, gm, S, E); }
    }
    GSYNC();
    {
        KParams kp = kparams(); unsigned char* ws = kp->ws;
        pg8::StaticOrder S; S.init(MT, DM, (int)gridDim.x, (int)blockIdx.x);
        pg8::Gemm gm{WSP(bf16_t, WS_Y), WSP(bf16_t, WS_WOUT), MT, DM, DM, DM, DM}; EpiOut E{kp->x, WSP(bf16_t, WS_X1B), WSP(float, WS_SS2)};
        pg8::gemm_phase<EpiOut, pg8::StaticOrder>(wv, lds, gm, S, E);
    }
    GSYNC();
    {
        KParams kp = kparams(); unsigned char* ws = kp->ws;
        pg8::StaticOrder S; S.init(MT, DFF, (int)gridDim.x, (int)blockIdx.x);
        pg8::Gemm gm{WSP(bf16_t, WS_X1B), WSP(bf16_t, WS_WUP), MT, DFF, DM, DM, DM}; EpiUp E{WSP(float, WS_SS2), WSP(bf16_t, WS_H)};
        pg8::gemm_phase<EpiUp, pg8::StaticOrder>(wv, lds, gm, S, E);
    }
    GSYNC();
    {
        KParams kp = kparams(); unsigned char* ws = kp->ws;
        pg8::StaticOrder S; S.init(MT, DM, (int)gridDim.x, (int)blockIdx.x);
        pg8::Gemm gm{WSP(bf16_t, WS_H), WSP(bf16_t, WS_WDN), MT, DM, DFF, DFF, DFF}; EpiDown E{WSP(bf16_t, WS_X1B), kp->out};
        pg8::gemm_phase<EpiDown, pg8::StaticOrder>(wv, lds, gm, S, E);
    }
}

extern "C" void kernel_launch(void* const* d_in, const int* in_sizes, int n_in, void* d_out, int out_size, void* d_ws, size_t ws_size, hipStream_t stream) {
    static int grid_blocks = 0;
    if (grid_blocks == 0) {
        if (ws_size < WS_END) { fprintf(stderr, "kernel_launch: workspace too small: %zu < %zu\n", ws_size, (size_t)WS_END); grid_blocks = -1; return; }
        int dev = 0, cus = 0, per_cu = 0;
        hipGetDevice(&dev);
        hipDeviceGetAttribute(&cus, hipDeviceAttributeMultiprocessorCount, dev);
        if (hipFuncSetAttribute((const void*)mega, hipFuncAttributeMaxDynamicSharedMemorySize, LDS_BYTES) != hipSuccess) { fprintf(stderr, "kernel_launch: hipFuncSetAttribute failed\n"); grid_blocks = -1; return; }
        if (hipOccupancyMaxActiveBlocksPerMultiprocessor(&per_cu, (const void*)mega, 512, LDS_BYTES) != hipSuccess || per_cu < 1) { fprintf(stderr, "kernel_launch: occupancy query failed (%d)\n", per_cu); per_cu = 1; (void)hipGetLastError(); }
        grid_blocks = cus * per_cu;
    }
    if (grid_blocks < 0) return;
    Params p{};
    p.x = (const float*)d_in[0]; p.norm1_g = (const float*)d_in[1]; p.w_in = (const float*)d_in[2]; p.q_norm_g = (const float*)d_in[3]; p.k_norm_g = (const float*)d_in[4];
    p.gn_g = (const float*)d_in[5]; p.gn_b = (const float*)d_in[6]; p.w_pa = (const float*)d_in[7]; p.w_pb = (const float*)d_in[8]; p.w_out = (const float*)d_in[9];
    p.norm2_g = (const float*)d_in[10]; p.w_up = (const float*)d_in[11]; p.w_dn = (const float*)d_in[12];
    p.out = (float*)d_out; p.ws = (unsigned char*)d_ws;
    if (hipMemsetAsync((char*)d_ws + WS_BAR, 0, XCD_BAR_WORDS * 4, stream) != hipSuccess) { fprintf(stderr, "kernel_launch: memset failed\n"); return; }
    void* args[] = {&p};
    hipError_t e = hipLaunchCooperativeKernel((const void*)mega, dim3(grid_blocks), dim3(512), args, LDS_BYTES, stream);
    if (e != hipSuccess) fprintf(stderr, "cooperative launch failed: %s (grid %d)\n", hipGetErrorString(e), grid_blocks);
}
```

```cpp
#include <hip/hip_runtime.h>
#include <hip/hip_cooperative_groups.h>
#include <cstdio>
#ifndef REP_A
#define REP_A 1
#endif
#ifndef REP_B1
#define REP_B1 1
#endif
#ifndef REP_B3
#define REP_B3 1
#endif
#ifndef REP_SYNC
#define REP_SYNC 1
#endif
namespace cg = cooperative_groups;

#define LAS __attribute__((address_space(3)))
typedef unsigned short bf16_t;
typedef short bf16x8 __attribute__((ext_vector_type(8)));
typedef float f32x4 __attribute__((ext_vector_type(4)));
typedef unsigned u32x4 __attribute__((ext_vector_type(4)));
typedef unsigned u32x2 __attribute__((ext_vector_type(2)));

constexpr int MT = 32768, TB = 8192, DM = 1024, INW = 12800, DFF = 4096;
constexpr int QKVR_LD = 8704;
constexpr int C_AQ = 0, C_AK = 1536, C_AV = 3072, C_RQ = 4608, C_RK = 5632, C_RV = 6656;
constexpr float EPS = 1e-6f;
constexpr int LDS_BYTES = 139264;
constexpr int PA = 272;
constexpr int PR = 528;

constexpr size_t MiB = 1024 * 1024;
constexpr size_t WS_WIN = 0;
constexpr size_t WS_WPA = WS_WIN + 25 * MiB;
constexpr size_t WS_WPB = WS_WPA + 1 * MiB;
constexpr size_t WS_WOUT = WS_WPB + 4 * MiB;
constexpr size_t WS_WUP = WS_WOUT + 2 * MiB;
constexpr size_t WS_WDN = WS_WUP + 8 * MiB;
constexpr size_t WS_RSTD1 = WS_WDN + 8 * MiB;
constexpr size_t WS_BAR = WS_RSTD1 + 512 * 1024;
constexpr size_t WS_SS2 = WS_RSTD1 + 1 * MiB;
constexpr size_t WS_LSE = WS_SS2 + 2 * MiB;
constexpr size_t WS_OG = WS_LSE + 1 * MiB;
constexpr size_t WS_KV = WS_OG + 24 * MiB;
constexpr size_t WS_R0 = WS_KV + 64 * MiB;
constexpr size_t WS_GR = WS_R0 + 136 * MiB;
constexpr size_t WS_R1 = WS_R0 + 168 * MiB;
constexpr size_t WS_OA = WS_R1;
constexpr size_t WS_OR = WS_R1 + 32 * MiB;
constexpr size_t WS_END = WS_R1 + 160 * MiB;
constexpr size_t WS_X1B = WS_R0;
constexpr size_t WS_Y = WS_R0 + 64 * MiB;
constexpr size_t WS_H = WS_R0 + 64 * MiB;

struct Params {
    const float* x; const float* norm1_g; const float* w_in; const float* q_norm_g; const float* k_norm_g;
    const float* gn_g; const float* gn_b; const float* w_pa; const float* w_pb; const float* w_out;
    const float* norm2_g; const float* w_up; const float* w_dn;
    float* out; unsigned char* ws;
};

__device__ __forceinline__ int lane_id_() { int l; asm volatile("v_mbcnt_lo_u32_b32 %0, -1, 0\n\tv_mbcnt_hi_u32_b32 %0, -1, %0" : "=v"(l)); return l; }
#define TIDX (wv * 64 + lane_id_())
__device__ __forceinline__ float shx(float v, int lane, int mask) { return __int_as_float(__builtin_amdgcn_ds_bpermute((lane ^ mask) << 2, __float_as_int(v))); }
__device__ __forceinline__ float shl(float v, int src) { return __int_as_float(__builtin_amdgcn_ds_bpermute(src << 2, __float_as_int(v))); }
__device__ __forceinline__ unsigned cvt_pk_bf16(float lo, float hi) { unsigned r; asm volatile("v_cvt_pk_bf16_f32 %0, %1, %2" : "=v"(r) : "v"(lo), "v"(hi)); return r; }
__device__ __forceinline__ float bflo(unsigned u) { return __uint_as_float(u << 16); }
__device__ __forceinline__ float bfhi(unsigned u) { return __uint_as_float(u & 0xffff0000u); }
__device__ __forceinline__ float bf2f(bf16_t b) { return __uint_as_float(((unsigned)b) << 16); }
__device__ __forceinline__ bf16_t f2bf(float f) { return (bf16_t)(cvt_pk_bf16(f, 0.f) & 0xffffu); }
__device__ __forceinline__ float sigmoidf_(float v) { return __builtin_amdgcn_rcpf(1.0f + __expf(-v)); }
union Frag { bf16x8 v; u32x4 u; };

__device__ __forceinline__ bf16x8 tr_frag(unsigned a0, unsigned a1) {
    u32x2 r0, r1;
    asm volatile("ds_read_b64_tr_b16 %0, %2\n\tds_read_b64_tr_b16 %1, %3\n\ts_waitcnt lgkmcnt(0)" : "=&v"(r0), "=&v"(r1) : "v"(a0), "v"(a1) : "memory");
    Frag f; f.u = (u32x4){r0.x, r0.y, r1.x, r1.y}; return f.v;
}
__device__ __forceinline__ void tr_frag4(unsigned a0, unsigned a1, unsigned d0, unsigned d1, unsigned d2, unsigned d3, bf16x8& f0, bf16x8& f1, bf16x8& f2, bf16x8& f3) {
    u32x2 r0, r1, r2, r3, r4, r5, r6, r7;
    const unsigned x0 = a0 + d0, y0 = a1 + d0, x1 = a0 + d1, y1 = a1 + d1, x2 = a0 + d2, y2 = a1 + d2, x3 = a0 + d3, y3 = a1 + d3;
    asm volatile("ds_read_b64_tr_b16 %0, %8\n\tds_read_b64_tr_b16 %1, %9\n\tds_read_b64_tr_b16 %2, %10\n\tds_read_b64_tr_b16 %3, %11\n\t"
                 "ds_read_b64_tr_b16 %4, %12\n\tds_read_b64_tr_b16 %5, %13\n\tds_read_b64_tr_b16 %6, %14\n\tds_read_b64_tr_b16 %7, %15\n\ts_waitcnt lgkmcnt(0)"
                 : "=&v"(r0), "=&v"(r1), "=&v"(r2), "=&v"(r3), "=&v"(r4), "=&v"(r5), "=&v"(r6), "=&v"(r7)
                 : "v"(x0), "v"(y0), "v"(x1), "v"(y1), "v"(x2), "v"(y2), "v"(x3), "v"(y3) : "memory");
    Frag f; f.u = (u32x4){r0.x, r0.y, r1.x, r1.y}; f0 = f.v; f.u = (u32x4){r2.x, r2.y, r3.x, r3.y}; f1 = f.v;
    f.u = (u32x4){r4.x, r4.y, r5.x, r5.y}; f2 = f.v; f.u = (u32x4){r6.x, r6.y, r7.x, r7.y}; f3 = f.v;
}
#define MFMA16(a, b, c) __builtin_amdgcn_mfma_f32_16x16x32_bf16((a), (b), (c), 0, 0, 0)

namespace pg8 {
constexpr int BM = 256, BK = 64, HALF = 128, HTB = HALF * BK * 2, STAGE_BYTES = 8 * HTB, NXCD = 8, WGM = 8;
__device__ __forceinline__ int lds_byte(int r, int c) { const int st = (r >> 4) * 2 + (c >> 5), rr = r & 15, cc = c & 31, ob = rr * 64 + cc * 2; return st * 1024 + (ob ^ (((ob >> 9) & 1) << 5)); }
__device__ __forceinline__ void stage_rc(int b, int& R, int& C) { const int st = b / 1024, sb = b % 1024, swz = sb ^ (((sb >> 9) & 1) << 5); R = (st >> 1) * 16 + swz / 64; C = (st & 1) * 32 + (swz % 64) / 2; }
__device__ __forceinline__ int perm32(int rho) { const int n = rho >> 4, i = rho & 15; return 8 * (i >> 2) + 4 * n + (i & 3); }
struct Unit { int pm, pn; };
struct Gemm { const bf16_t* A; const bf16_t* Bt; int M, N, K, lda, ldb; int atile = 0; };
struct StaticOrder {
    int nM, nN, nwg, G, c;
    __device__ void init(int M, int N, int G_, int c_) { nM = M / BM; nN = N / BM; nwg = nM * nN; G = G_; c = c_; }
    __device__ bool next(int i, Unit& u) const {
        const long L = (long)i * G + c; if (L >= nwg) return false;
        int wgid = (int)L; { const int q = nwg / NXCD, r = nwg % NXCD, xcd = wgid % NXCD, off = wgid / NXCD; wgid = (xcd < r ? xcd * (q + 1) : r * (q + 1) + (xcd - r) * q) + off; }
        const int nig = WGM * nN, gid = wgid / nig, fm = gid * WGM, gsz = (nM - fm) < WGM ? (nM - fm) : WGM;
        u.pm = fm + ((wgid % nig) % gsz); u.pn = (wgid % nig) / gsz; return true;
    }
    __device__ __forceinline__ void a_ready(const Unit&) const {}
    __device__ __forceinline__ void done(const Unit&) const {}
};

template <class Epi, class Sched>
__device__ __forceinline__ void gemm_phase(const int wv, LAS unsigned char* lds, const Gemm g, const Sched& S, const Epi& E) {
    int tid_ = TIDX; asm volatile("" : "+v"(tid_));
    const int tid = tid_, wid = __builtin_amdgcn_readfirstlane(tid >> 6), lane = tid & 63, wr = wid >> 2, wc = wid & 3, fr = lane & 15, fq = lane >> 4;
    const int K = g.K, nt = K / BK;
    unsigned voffA[2], voffB[2];
#pragma unroll
    for (int i = 0; i < 2; ++i) { int R, C; stage_rc(tid * 16 + i * 8192, R, C); const int Rb = Epi::PERM ? ((R & ~31) + perm32(R & 31)) : R;
        voffA[i] = (unsigned)(R * (g.atile ? BK : g.lda) + C) * 2u; voffB[i] = (unsigned)(Rb * g.ldb + C) * 2u; }
    const size_t kstep = (size_t)(BK * 2);
    const int ldaE = g.atile ? BK : g.lda;
    const size_t kstepA = g.atile ? (size_t)BM * BK * 2 : kstep;
    const size_t hstepA = (size_t)HALF * ldaE * 2, hstepB = (size_t)HALF * g.ldb * 2;
    const size_t tstepA = g.atile ? (size_t)(g.K / BK) * BM * BK * 2 : 2 * hstepA, tstepB = 2 * hstepB;
    const unsigned ldsw = (unsigned)wid * 1024u;
    const int aoff = lds_byte(wr * 64 + fr, fq * 8), boff = lds_byte(wc * 32 + fr, fq * 8);
#define PG8_SA(b, h) (((b) * 2 + (h)) * HTB)
#define PG8_SB(b, h) ((4 + (b) * 2 + (h)) * HTB)
#define PG8_STAGE(bufoff, gbase, voff) do { _Pragma("unroll") for (int _i = 0; _i < 2; ++_i) \
        __builtin_amdgcn_global_load_lds((const unsigned*)((const char*)(gbase) + (voff)[_i]), (LAS unsigned*)(lds + (bufoff) + ldsw + _i * 8192), 16, 0, 0); } while (0)
#define PG8_LDA(dst, b, h) do { _Pragma("unroll") for (int m = 0; m < 4; ++m) _Pragma("unroll") for (int k = 0; k < 2; ++k) dst[m][k] = *(const LAS bf16x8*)(lds + PG8_SA(b, h) + aoff + m * 2048 + k * 1024); } while (0)
#define PG8_LDB(dst, b, h) do { _Pragma("unroll") for (int n = 0; n < 2; ++n) _Pragma("unroll") for (int k = 0; k < 2; ++k) dst[n][k] = *(const LAS bf16x8*)(lds + PG8_SB(b, h) + boff + n * 2048 + k * 1024); } while (0)
#define PG8_MMA(ai, bj, At, Bt) do { __builtin_amdgcn_s_setprio(1); _Pragma("unroll") for (int m = 0; m < 4; ++m) _Pragma("unroll") for (int n = 0; n < 2; ++n) _Pragma("unroll") for (int k = 0; k < 2; ++k) \
        acc[ai][bj][m][n] = __builtin_amdgcn_mfma_f32_16x16x32_bf16(Bt[n][k], At[m][k], acc[ai][bj][m][n], 0, 0, 0); __builtin_amdgcn_s_setprio(0); } while (0)
#define PG8_WAIT_V(n) asm volatile("s_waitcnt vmcnt(" #n ")" ::: "memory")
#define PG8_WAIT_L(n) asm volatile("s_waitcnt lgkmcnt(" #n ")" ::: "memory")
#define PG8_BAR __builtin_amdgcn_s_barrier()
#define PG8_SCHED __builtin_amdgcn_sched_barrier(0)
    Unit cur, nxt; int ui = 0;
    if (!S.next(0, cur)) return;
    f32x4 acc[2][2][4][2];
#pragma unroll
    for (int a = 0; a < 2; ++a)
#pragma unroll
        for (int b = 0; b < 2; ++b)
#pragma unroll
            for (int m = 0; m < 4; ++m)
#pragma unroll
                for (int n = 0; n < 2; ++n) acc[a][b][m][n] = (f32x4){0.f, 0.f, 0.f, 0.f};
    bf16x8 At[4][2], B0[2][2], B1[2][2];
    const char* cA = (const char*)g.A + (size_t)cur.pm * tstepA; const char* cB = (const char*)g.Bt + (size_t)cur.pn * tstepB;
    S.a_ready(cur);
    PG8_STAGE(PG8_SB(0, 0), cB, voffB); PG8_STAGE(PG8_SA(0, 0), cA, voffA); PG8_STAGE(PG8_SB(0, 1), cB + hstepB, voffB); PG8_STAGE(PG8_SA(0, 1), cA + hstepA, voffA);
    if (wr == 1) PG8_BAR;
    PG8_WAIT_V(4); PG8_BAR;
    PG8_STAGE(PG8_SB(1, 0), cB + kstep, voffB); PG8_STAGE(PG8_SA(1, 0), cA + kstepA, voffA); PG8_STAGE(PG8_SB(1, 1), cB + hstepB + kstep, voffB);
    PG8_WAIT_V(6); PG8_BAR;
    for (;;) {
        const bool has_next = S.next(ui + 1, nxt);
        const char* nA = has_next ? (const char*)g.A + (size_t)nxt.pm * tstepA : cA; const char* nB = has_next ? (const char*)g.Bt + (size_t)nxt.pn * tstepB : cB;
        for (int t = 0; t < nt; t += 2) {
            const bool last = (t == nt - 2);
            const char* a1 = cA + (size_t)(t + 1) * kstepA;
            const char* a2 = last ? nA : cA + (size_t)(t + 2) * kstepA; const char* b2 = last ? nB : cB + (size_t)(t + 2) * kstep;
            const char* a3 = a2 + kstepA; const char* b3 = b2 + kstep;
            if (last && has_next) S.a_ready(nxt);
            PG8_LDB(B0, 0, 0); PG8_SCHED; PG8_LDA(At, 0, 0); PG8_STAGE(PG8_SA(1, 1), a1 + hstepA, voffA);
            PG8_WAIT_L(8); PG8_BAR; PG8_WAIT_L(0); PG8_MMA(0, 0, At, B0); PG8_BAR; PG8_SCHED;
            PG8_LDB(B1, 0, 1); PG8_STAGE(PG8_SB(0, 0), b2, voffB);
            PG8_BAR; PG8_WAIT_L(0); PG8_MMA(0, 1, At, B1); PG8_BAR;
            PG8_LDA(At, 0, 1); PG8_STAGE(PG8_SA(0, 0), a2, voffA);
            PG8_BAR; PG8_WAIT_L(0); PG8_MMA(1, 0, At, B0); PG8_BAR; PG8_SCHED;
            PG8_STAGE(PG8_SB(0, 1), b2 + hstepB, voffB);
            PG8_WAIT_V(6); PG8_BAR; PG8_MMA(1, 1, At, B1); PG8_BAR;
            PG8_LDB(B0, 1, 0); PG8_SCHED; PG8_LDA(At, 1, 0); PG8_STAGE(PG8_SA(0, 1), a2 + hstepA, voffA);
            PG8_WAIT_L(8); PG8_BAR; PG8_WAIT_L(0); PG8_MMA(0, 0, At, B0); PG8_BAR; PG8_SCHED;
            PG8_LDB(B1, 1, 1); PG8_STAGE(PG8_SB(1, 0), b3, voffB);
            PG8_BAR; PG8_WAIT_L(0); PG8_MMA(0, 1, At, B1); PG8_BAR;
            PG8_LDA(At, 1, 1); PG8_STAGE(PG8_SA(1, 0), a3, voffA);
            PG8_BAR; PG8_WAIT_L(0); PG8_MMA(1, 0, At, B0); PG8_BAR; PG8_SCHED;
            PG8_STAGE(PG8_SB(1, 1), b3 + hstepB, voffB);
            PG8_WAIT_V(6); PG8_BAR; PG8_MMA(1, 1, At, B1); PG8_BAR;
        }
        E(acc, cur, wr, wc, fr, fq); S.done(cur);
        if (!has_next) break;
#pragma unroll
        for (int a = 0; a < 2; ++a)
#pragma unroll
            for (int b = 0; b < 2; ++b)
#pragma unroll
                for (int m = 0; m < 4; ++m)
#pragma unroll
                    for (int n = 0; n < 2; ++n) acc[a][b][m][n] = (f32x4){0.f, 0.f, 0.f, 0.f};
        cur = nxt; cA = nA; cB = nB; ++ui;
    }
    PG8_WAIT_V(0);
    if (wr == 0) PG8_BAR;
    PG8_BAR;
#undef PG8_SA
#undef PG8_SB
#undef PG8_STAGE
#undef PG8_LDA
#undef PG8_LDB
#undef PG8_MMA
#undef PG8_WAIT_V
#undef PG8_WAIT_L
#undef PG8_BAR
#undef PG8_SCHED
}
}
using pg8::Unit;

struct EpiIn {
    static constexpr bool PERM = true;
    bf16_t* qkvr; bf16_t* gr; bf16_t* gates;
    __device__ __forceinline__ void operator()(const f32x4 (&acc)[2][2][4][2], const Unit& u, int wr, int wc, int fr, int fq) const {
        const int row0 = (u.pm >> 6) * TB + (u.pm & 63) * 256 + wr * 64 + fr; const int pn = u.pn;
        bf16_t* base; int ld, colt, act;
        if (pn < 34) { base = qkvr; ld = QKVR_LD; colt = pn * 256; act = 0; }
        else if (pn < 42) { base = gr; ld = 2048; colt = (pn - 34) * 256; act = 1; }
        else { base = gates; ld = 2048; colt = (pn - 42) * 256; act = 2; }
        const int col0 = colt + wc * 32 + 8 * fq;
#pragma unroll
        for (int ai = 0; ai < 2; ++ai)
#pragma unroll
            for (int m = 0; m < 4; ++m) {
                const int row = row0 + ai * 128 + m * 16; float rs = 1.0f;
                if (pn >= 22 && pn < 26) rs = exp2f(log2f(1.0f - exp2f(-5.0f - (float)(pn - 22))) * (float)(127 - (row & 127)));
                bf16_t* rowp = base + (size_t)row * ld + col0;
#pragma unroll
                for (int bj = 0; bj < 2; ++bj) {
                    f32x4 v0 = acc[ai][bj][m][0] * rs, v1 = acc[ai][bj][m][1] * rs;
                    if (act == 1) {
#pragma unroll
                        for (int j = 0; j < 4; ++j) { v0[j] = v0[j] * sigmoidf_(v0[j]); v1[j] = v1[j] * sigmoidf_(v1[j]); }
                    } else if (act == 2) {
#pragma unroll
                        for (int j = 0; j < 4; ++j) { v0[j] = sigmoidf_(v0[j]); v1[j] = sigmoidf_(v1[j]); }
                    }
                    u32x4 w; w.x = cvt_pk_bf16(v0[0], v0[1]); w.y = cvt_pk_bf16(v0[2], v0[3]); w.z = cvt_pk_bf16(v1[0], v1[1]); w.w = cvt_pk_bf16(v1[2], v1[3]);
                    *(u32x4*)(rowp + bj * 128) = w;
                }
            }
    }
};
template <int SECOND> struct EpiGate {
    static constexpr bool PERM = true;
    const bf16_t* gates; bf16_t* Y;
    __device__ __forceinline__ void operator()(const f32x4 (&acc)[2][2][4][2], const Unit& u, int wr, int wc, int fr, int fq) const {
        const int row0 = u.pm * 256 + wr * 64 + fr; const int col0 = u.pn * 256 + wc * 32 + 8 * fq;
#pragma unroll
        for (int ai = 0; ai < 2; ++ai) {
            u32x4 gv[4][2], yv[4][2];
#pragma unroll
            for (int m = 0; m < 4; ++m)
#pragma unroll
                for (int bj = 0; bj < 2; ++bj) {
                    const int row = row0 + ai * 128 + m * 16, col = col0 + bj * 128;
                    gv[m][bj] = *(const u32x4*)(gates + (size_t)row * 2048 + SECOND * 1024 + col);
                    if (SECOND) yv[m][bj] = *(const u32x4*)(Y + (size_t)row * 1024 + col);
                }
#pragma unroll
            for (int m = 0; m < 4; ++m)
#pragma unroll
                for (int bj = 0; bj < 2; ++bj) {
                    const int row = row0 + ai * 128 + m * 16, col = col0 + bj * 128;
                    const u32x4 g = gv[m][bj];
                    const f32x4 a0 = acc[ai][bj][m][0], a1 = acc[ai][bj][m][1];
                    float r[8] = {a0[0] * bflo(g.x), a0[1] * bfhi(g.x), a0[2] * bflo(g.y), a0[3] * bfhi(g.y), a1[0] * bflo(g.z), a1[1] * bfhi(g.z), a1[2] * bflo(g.w), a1[3] * bfhi(g.w)};
                    if (SECOND) { const u32x4 y = yv[m][bj];
                        r[0] += bflo(y.x); r[1] += bfhi(y.x); r[2] += bflo(y.y); r[3] += bfhi(y.y); r[4] += bflo(y.z); r[5] += bfhi(y.z); r[6] += bflo(y.w); r[7] += bfhi(y.w); }
                    u32x4 w; w.x = cvt_pk_bf16(r[0], r[1]); w.y = cvt_pk_bf16(r[2], r[3]); w.z = cvt_pk_bf16(r[4], r[5]); w.w = cvt_pk_bf16(r[6], r[7]);
                    *(u32x4*)(Y + (size_t)row * 1024 + col) = w;
                }
        }
    }
};
struct EpiOut {
    static constexpr bool PERM = true;
    const float* x; bf16_t* x1b; float* ss2;
    __device__ __forceinline__ void operator()(const f32x4 (&acc)[2][2][4][2], const Unit& u, int wr, int wc, int fr, int fq) const {
        const int row0 = u.pm * 256 + wr * 64 + fr; const int col0 = u.pn * 256 + wc * 32 + 8 * fq;
#pragma unroll
        for (int ai = 0; ai < 2; ++ai) {
            f32x4 xv[4][2][2];
#pragma unroll
            for (int m = 0; m < 4; ++m)
#pragma unroll
                for (int bj = 0; bj < 2; ++bj) {
                    const size_t o = (size_t)(row0 + ai * 128 + m * 16) * 1024 + col0 + bj * 128;
                    xv[m][bj][0] = *(const f32x4*)(x + o); xv[m][bj][1] = *(const f32x4*)(x + o + 4);
                }
#pragma unroll
            for (int m = 0; m < 4; ++m) {
                const int row = row0 + ai * 128 + m * 16; float ss = 0.f;
#pragma unroll
                for (int bj = 0; bj < 2; ++bj) {
                    const size_t o = (size_t)row * 1024 + col0 + bj * 128;
                    const f32x4 v0 = xv[m][bj][0] + acc[ai][bj][m][0], v1 = xv[m][bj][1] + acc[ai][bj][m][1];
                    ss += (v0[0] * v0[0] + v0[1] * v0[1]) + (v0[2] * v0[2] + v0[3] * v0[3]) + (v1[0] * v1[0] + v1[1] * v1[1]) + (v1[2] * v1[2] + v1[3] * v1[3]);
                    u32x4 w; w.x = cvt_pk_bf16(v0[0], v0[1]); w.y = cvt_pk_bf16(v0[2], v0[3]); w.z = cvt_pk_bf16(v1[0], v1[1]); w.w = cvt_pk_bf16(v1[2], v1[3]);
                    *(u32x4*)(x1b + o) = w;
                }
                ss += shx(ss, fq * 16 + fr, 16); ss += shx(ss, fq * 16 + fr, 32);
                ss2[(size_t)row * 16 + u.pn * 4 + wc] = ss;
            }
        }
    }
};
struct EpiUp {
    static constexpr bool PERM = true;
    const float* ss2; bf16_t* H;
    __device__ __forceinline__ void operator()(const f32x4 (&acc)[2][2][4][2], const Unit& u, int wr, int wc, int fr, int fq) const {
        const int row0 = u.pm * 256 + wr * 64 + fr; const int col0 = u.pn * 256 + wc * 32 + 8 * fq;
        f32x4 sq[2][4];
#pragma unroll
        for (int ai = 0; ai < 2; ++ai)
#pragma unroll
            for (int m = 0; m < 4; ++m) sq[ai][m] = *(const f32x4*)(ss2 + (size_t)(row0 + ai * 128 + m * 16) * 16 + 4 * fq);
#pragma unroll
        for (int ai = 0; ai < 2; ++ai)
#pragma unroll
            for (int m = 0; m < 4; ++m) {
                const int row = row0 + ai * 128 + m * 16;
                float ss = (sq[ai][m][0] + sq[ai][m][1]) + (sq[ai][m][2] + sq[ai][m][3]);
                ss += shx(ss, fq * 16 + fr, 16); ss += shx(ss, fq * 16 + fr, 32);
                const float rs = rsqrtf(ss * (1.0f / 1024.0f) + EPS);
#pragma unroll
                for (int bj = 0; bj < 2; ++bj) {
                    f32x4 v0 = acc[ai][bj][m][0] * rs, v1 = acc[ai][bj][m][1] * rs;
#pragma unroll
                    for (int j = 0; j < 4; ++j) { const float a = fmaxf(v0[j], 0.f), b = fmaxf(v1[j], 0.f); v0[j] = a * a; v1[j] = b * b; }
                    u32x4 w; w.x = cvt_pk_bf16(v0[0], v0[1]); w.y = cvt_pk_bf16(v0[2], v0[3]); w.z = cvt_pk_bf16(v1[0], v1[1]); w.w = cvt_pk_bf16(v1[2], v1[3]);
                    { const int col = col0 + bj * 128;
                      *(u32x4*)(H + ((size_t)((row >> 8) * (DFF / 64) + (col >> 6)) * 256 + (row & 255)) * 64 + (col & 63)) = w; }
                }
            }
    }
};
struct EpiDown {
    static constexpr bool PERM = false;
    const bf16_t* x1b; float* out;
    __device__ __forceinline__ void operator()(const f32x4 (&acc)[2][2][4][2], const Unit& u, int wr, int wc, int fr, int fq) const {
        const int row0 = u.pm * 256 + wr * 64 + fr; const int col0 = u.pn * 256 + wc * 32 + 4 * fq;
        u32x2 xv[2][4][2][2];
#pragma unroll
        for (int ai = 0; ai < 2; ++ai)
#pragma unroll
            for (int m = 0; m < 4; ++m)
#pragma unroll
                for (int bj = 0; bj < 2; ++bj)
#pragma unroll
                    for (int n = 0; n < 2; ++n) xv[ai][m][bj][n] = *(const u32x2*)(x1b + (size_t)(row0 + ai * 128 + m * 16) * 1024 + col0 + bj * 128 + n * 16);
#pragma unroll
        for (int ai = 0; ai < 2; ++ai)
#pragma unroll
            for (int m = 0; m < 4; ++m)
#pragma unroll
                for (int bj = 0; bj < 2; ++bj)
#pragma unroll
                    for (int n = 0; n < 2; ++n) {
                        const size_t o = (size_t)(row0 + ai * 128 + m * 16) * 1024 + col0 + bj * 128 + n * 16;
                        const u32x2 v = xv[ai][m][bj][n]; const f32x4 a = acc[ai][bj][m][n];
                        *(f32x4*)(out + o) = (f32x4){bflo(v.x) + a[0], bfhi(v.x) + a[1], bflo(v.y) + a[2], bfhi(v.y) + a[3]};
                    }
    }
};

struct InProjOrder {
    pg8::StaticOrder so; int G, c, b, gstart, ng;
    __device__ void init(int b_, int G_, int c_) { so.init(TB, 42 * 256, G_, c_); G = G_; c = c_; b = b_; gstart = b_ == 0 ? 0 : 256 + 192 * b_; ng = b_ == 0 ? 448 : 192; }
    __device__ bool next(int i, Unit& u) const {
        const long L = (long)i * G + c;
        if (L < 1344) return so.next(i, u);
        const int gi = (int)L - 1344; if (gi >= ng) return false;
        const int gu = gstart + gi, bq = gu >> 8, wi = gu & 255;
        u.pm = (bq - b) * 64 + (wi >> 3); u.pn = 42 + (wi & 7); return true;
    }
    __device__ __forceinline__ void a_ready(const Unit&) const {}
    __device__ __forceinline__ void done(const Unit&) const {}
};

__device__ __forceinline__ void transpose_w(const int wv, LAS unsigned char* lds, const float* __restrict__ w, bf16_t* __restrict__ wt, int K, int N, const float* __restrict__ gk, int slo, int shi, float scale) {
    const int tk = K / 64, tn = N / 64, nt = tk * tn;
    const int t = TIDX, nl = t & 63, kg = t >> 6, n2 = t >> 3, kc = t & 7;
    for (int tile = blockIdx.x; tile < nt; tile += gridDim.x) {
        const int kt0 = (tile % tk) * 64, nb0 = (tile / tk) * 64;
        const int k0 = kt0 + kg * 8, n = nb0 + nl;
        float v[8];
#pragma unroll
        for (int j = 0; j < 8; ++j) { float g = gk ? gk[k0 + j] : 1.0f; v[j] = w[(size_t)(k0 + j) * N + n] * g; }
        if (n >= slo && n < shi) {
#pragma unroll
            for (int j = 0; j < 8; ++j) v[j] *= scale;
        }
        u32x4 o; o.x = cvt_pk_bf16(v[0], v[1]); o.y = cvt_pk_bf16(v[2], v[3]); o.z = cvt_pk_bf16(v[4], v[5]); o.w = cvt_pk_bf16(v[6], v[7]);
        *(LAS u32x4*)(lds + nl * 144 + kg * 16) = o;
        __syncthreads();
        *(u32x4*)(wt + (size_t)(nb0 + n2) * K + kt0 + kc * 8) = *(const LAS u32x4*)(lds + n2 * 144 + kc * 16);
        __syncthreads();
    }
}
__device__ __forceinline__ void prep_x(const int wv, const float* __restrict__ x, bf16_t* __restrict__ orbuf) {
    const int wave = TIDX >> 6, lane = TIDX & 63;
    const int rstride = gridDim.x * 8;
    for (int row0 = blockIdx.x * 8 + wave; row0 < MT; row0 += 4 * rstride) {
        f32x4 v[4][4];
#pragma unroll
        for (int q = 0; q < 4; ++q) { const int row = row0 + q * rstride;
            if (row < MT) {
#pragma unroll
                for (int i = 0; i < 4; ++i) v[q][i] = *(const f32x4*)(x + (size_t)row * DM + i * 256 + lane * 4);
            } }
#pragma unroll
        for (int q = 0; q < 4; ++q) { const int row = row0 + q * rstride;
            if (row < MT) {
                const int b = row / TB, r = row % TB;
                bf16_t* xo = orbuf + (size_t)b * TB * 2048 + (size_t)r * DM;
                float ss = 0.f;
#pragma unroll
                for (int i = 0; i < 4; ++i) ss += v[q][i][0] * v[q][i][0] + v[q][i][1] * v[q][i][1] + v[q][i][2] * v[q][i][2] + v[q][i][3] * v[q][i][3];
#pragma unroll
                for (int o = 1; o < 64; o <<= 1) ss += shx(ss, lane, o);
                const float rs = rsqrtf(ss * (1.0f / 1024.0f) + EPS);
#pragma unroll
                for (int i = 0; i < 4; ++i) { u32x2 w; w.x = cvt_pk_bf16(v[q][i][0] * rs, v[q][i][1] * rs); w.y = cvt_pk_bf16(v[q][i][2] * rs, v[q][i][3] * rs); *(u32x2*)(xo + i * 256 + lane * 4) = w; }
            } }
    }
}

__device__ __forceinline__ void attn_stream(const int wv, LAS unsigned char* lds, unsigned ldsb, const float* __restrict__ qng, const float* __restrict__ kng, const bf16_t* __restrict__ qkvr, bf16_t* __restrict__ og, float* __restrict__ lse,
                                            int first, int stride, int count) {
    int t_ = TIDX; asm volatile("" : "+v"(t_));
    const int t = t_, w = __builtin_amdgcn_readfirstlane(t >> 6), lane = t & 63, li = lane & 15, g = lane >> 4;
    if (first >= count) return;
    const unsigned QI = 0, KI = 128 * PA;
    const int c16 = t & 15, c160 = t & 15, rr0 = t >> 4, rr = t >> 4;
    u32x4 qr[4], kr[8], vr[8];
#define ATTN_GEOM(item_) const int hh = (item_) >> 6, blk = (item_) & 63; const int grp = hh >> 2, dil = grp == 0 ? 1 : (grp == 1 ? 4 : 16), nb = 64 / dil; const int r = blk / nb, n = blk % nb;
#define ATTN_LOAD_QK(item_) do { ATTN_GEOM(item_) int rr = rr0; asm volatile("" : "+v"(rr)); int c16 = c160; asm volatile("" : "+v"(c16)); \
        _Pragma("unroll") for (int it = 0; it < 4; ++it) { const int row = rr + 32 * it; qr[it] = *(const u32x4*)(qkvr + (size_t)((n * 128 + row) * dil + r) * QKVR_LD + C_AQ + hh * 128 + c16 * 8); } \
        _Pragma("unroll") for (int it = 0; it < 8; ++it) { const int l = n * 128 - 128 + rr + 32 * it; kr[it] = (u32x4){0u, 0u, 0u, 0u}; \
            if (l >= 0) kr[it] = *(const u32x4*)(qkvr + (size_t)(l * dil + r) * QKVR_LD + C_AK + hh * 128 + c16 * 8); } } while (0)
    int item = first;
    ATTN_LOAD_QK(item);
    for (;;) {
        ATTN_GEOM(item)
        const int inext = item + stride;
        {
            float gq[8], gk[8];
            int c8 = c16 * 8; asm volatile("" : "+v"(c8));
#pragma unroll
            for (int j = 0; j < 8; ++j) { gq[j] = qng[hh * 128 + c8 + j] * 0.08838834764831845f; gk[j] = kng[hh * 128 + c8 + j]; }
#pragma unroll
            for (int it = 0; it < 12; ++it) {
                const u32x4 v = it < 4 ? qr[it] : kr[it - 4];
                float f[8] = {bflo(v.x), bfhi(v.x), bflo(v.y), bfhi(v.y), bflo(v.z), bfhi(v.z), bflo(v.w), bfhi(v.w)};
                float ss = 0.f;
#pragma unroll
                for (int j = 0; j < 8; ++j) ss += f[j] * f[j];
                ss += shx(ss, lane, 1); ss += shx(ss, lane, 2); ss += shx(ss, lane, 4); ss += shx(ss, lane, 8);
                const float rs = rsqrtf(ss * (1.0f / 128.0f) + EPS);
#pragma unroll
                for (int j = 0; j < 8; ++j) f[j] *= rs * (it < 4 ? gq[j] : gk[j]);
                u32x4 o; o.x = cvt_pk_bf16(f[0], f[1]); o.y = cvt_pk_bf16(f[2], f[3]); o.z = cvt_pk_bf16(f[4], f[5]); o.w = cvt_pk_bf16(f[6], f[7]);
                if (it < 4) *(LAS u32x4*)(lds + QI + (rr + 32 * it) * PA + c16 * 16) = o;
                else *(LAS u32x4*)(lds + KI + (rr + 32 * (it - 4)) * PA + c16 * 16) = o;
            }
        }
        __syncthreads();
#pragma unroll
        for (int it = 0; it < 8; ++it) { const int l = n * 128 - 128 + rr + 32 * it; vr[it] = (u32x4){0u, 0u, 0u, 0u};
            if (l >= 0) vr[it] = *(const u32x4*)(qkvr + (size_t)(l * dil + r) * QKVR_LD + C_AV + hh * 128 + c16 * 8); }
        bf16x8 qf[4];
#pragma unroll
        for (int s2 = 0; s2 < 4; ++s2) qf[s2] = *(const LAS bf16x8*)(lds + QI + (16 * w + li) * PA + (32 * s2 + 8 * g) * 2);
        f32x4 sc[10];
#pragma unroll
        for (int t3 = 0; t3 < 9; t3 += 3) {
            bf16x8 kf[3][4];
#pragma unroll
            for (int q = 0; q < 3; ++q)
#pragma unroll
                for (int s2 = 0; s2 < 4; ++s2) kf[q][s2] = *(const LAS bf16x8*)(lds + KI + (16 * (w + t3 + q) + li) * PA + (32 * s2 + 8 * g) * 2);
            asm volatile("s_waitcnt lgkmcnt(0)" ::: "memory");
            f32x4 a0 = (f32x4){0.f, 0.f, 0.f, 0.f}, a1 = a0, a2 = a0;
#pragma unroll
            for (int s2 = 0; s2 < 4; ++s2) { a0 = MFMA16(kf[0][s2], qf[s2], a0); a1 = MFMA16(kf[1][s2], qf[s2], a1); a2 = MFMA16(kf[2][s2], qf[s2], a2); }
            sc[t3] = a0; sc[t3 + 1] = a1; sc[t3 + 2] = a2;
        }
        sc[9] = (f32x4){0.f, 0.f, 0.f, 0.f};
        const float slope = exp2f(-8.0f * (float)(hh + 1) / 12.0f) * (float)dil;
        const int qi = 16 * w + li;
        float mx = -3.0e38f;
#pragma unroll
        for (int tt = 0; tt < 9; ++tt)
#pragma unroll
            for (int e = 0; e < 4; ++e) {
                const int kj = 16 * (w + tt) + 4 * g + e; const int dist = 128 + qi - kj;
                const bool valid = (dist >= 0) && (dist <= 128) && (n > 0 || kj >= 128);
                const float sv = valid ? sc[tt][e] - slope * (float)dist : -3.0e38f;
                sc[tt][e] = sv; mx = fmaxf(mx, sv);
            }
        mx = fmaxf(mx, shx(mx, lane, 16)); mx = fmaxf(mx, shx(mx, lane, 32));
        float den = 0.f;
#pragma unroll
        for (int tt = 0; tt < 9; ++tt)
#pragma unroll
            for (int e = 0; e < 4; ++e) { const float sv = sc[tt][e]; const float pv = (sv > -1.0e38f) ? __expf(sv - mx) : 0.f; sc[tt][e] = pv; den += pv; }
        den += shx(den, lane, 16); den += shx(den, lane, 32);
        bf16x8 pf[5];
#pragma unroll
        for (int u = 0; u < 5; ++u) { Frag f; f.u.x = cvt_pk_bf16(sc[2 * u][0], sc[2 * u][1]); f.u.y = cvt_pk_bf16(sc[2 * u][2], sc[2 * u][3]); f.u.z = cvt_pk_bf16(sc[2 * u + 1][0], sc[2 * u + 1][1]); f.u.w = cvt_pk_bf16(sc[2 * u + 1][2], sc[2 * u + 1][3]); pf[u] = f.v; }
        __syncthreads();
#pragma unroll
        for (int it = 0; it < 8; ++it) *(LAS u32x4*)(lds + KI + (rr + 32 * it) * PA + c16 * 16) = vr[it];
        __syncthreads();
        if (inext < count) ATTN_LOAD_QK(inext);
        f32x4 oacc[8];
#pragma unroll
        for (int c = 0; c < 8; ++c) oacc[c] = (f32x4){0.f, 0.f, 0.f, 0.f};
        const int q4 = li >> 2, p4 = lane & 3;
#pragma unroll
        for (int u = 0; u < 5; ++u) {
            int kt0 = w + 2 * u, kt1 = w + 2 * u + 1; kt0 = kt0 > 15 ? 15 : kt0; kt1 = kt1 > 15 ? 15 : kt1;
            const unsigned a0 = ldsb + KI + (16 * kt0 + 4 * g + q4) * PA + 8 * p4;
            const unsigned a1 = ldsb + KI + (16 * kt1 + 4 * g + q4) * PA + 8 * p4;
#pragma unroll
            for (int c = 0; c < 8; c += 4) {
                bf16x8 v0, v1, v2, v3;
                tr_frag4(a0, a1, 32u * c, 32u * (c + 1), 32u * (c + 2), 32u * (c + 3), v0, v1, v2, v3);
                oacc[c] = MFMA16(pf[u], v0, oacc[c]); oacc[c + 1] = MFMA16(pf[u], v1, oacc[c + 1]);
                oacc[c + 2] = MFMA16(pf[u], v2, oacc[c + 2]); oacc[c + 3] = MFMA16(pf[u], v3, oacc[c + 3]);
            }
        }
        if (g == 0) lse[(size_t)((n * 128 + qi) * dil + r) * 12 + hh] = mx + __logf(den);
#pragma unroll
        for (int e = 0; e < 4; ++e) {
            const float inv = 1.0f / shl(den, 4 * g + e);
#pragma unroll
            for (int c = 0; c < 8; ++c) *(LAS bf16_t*)(lds + QI + (16 * w + 4 * g + e) * PA + (16 * c + li) * 2) = f2bf(oacc[c][e] * inv);
        }
        __syncthreads();
#pragma unroll
        for (int k = 0; k < 4; ++k) {
            const int id = t + 512 * k, row = id >> 4, ch = id & 15;
            *(u32x4*)(og + (size_t)((n * 128 + row) * dil + r) * 1536 + hh * 128 + ch * 8) = *(const LAS u32x4*)(lds + QI + row * PA + ch * 16);
        }
        __syncthreads();
        if (inext >= count) break;
        item = inext;
    }
#undef ATTN_GEOM
#undef ATTN_LOAD_QK
}

__device__ __forceinline__ unsigned sw512(unsigned row, unsigned chunk) { return row * 512u + ((chunk ^ (row & 15u)) << 4); }
#define DMA16(gp, lp) __builtin_amdgcn_global_load_lds((const unsigned*)(gp), (LAS unsigned*)(lp), 16, 0, 0)
#define WAITV0() asm volatile("s_waitcnt vmcnt(0)" ::: "memory")
#define LBAR() do { asm volatile("s_waitcnt lgkmcnt(0)" ::: "memory"); __builtin_amdgcn_s_barrier(); asm volatile("" ::: "memory"); } while (0)
__device__ __forceinline__ void tr_frag4x(unsigned x0, unsigned y0, unsigned x1, unsigned y1, unsigned x2, unsigned y2, unsigned x3, unsigned y3, bf16x8& f0, bf16x8& f1, bf16x8& f2, bf16x8& f3) {
    u32x2 r0, r1, r2, r3, r4, r5, r6, r7;
    asm volatile("ds_read_b64_tr_b16 %0, %8\n\tds_read_b64_tr_b16 %1, %9\n\tds_read_b64_tr_b16 %2, %10\n\tds_read_b64_tr_b16 %3, %11\n\t"
                 "ds_read_b64_tr_b16 %4, %12\n\tds_read_b64_tr_b16 %5, %13\n\tds_read_b64_tr_b16 %6, %14\n\tds_read_b64_tr_b16 %7, %15\n\ts_waitcnt lgkmcnt(0)"
                 : "=&v"(r0), "=&v"(r1), "=&v"(r2), "=&v"(r3), "=&v"(r4), "=&v"(r5), "=&v"(r6), "=&v"(r7)
                 : "v"(x0), "v"(y0), "v"(x1), "v"(y1), "v"(x2), "v"(y2), "v"(x3), "v"(y3) : "memory");
    Frag f; f.u = (u32x4){r0.x, r0.y, r1.x, r1.y}; f0 = f.v; f.u = (u32x4){r2.x, r2.y, r3.x, r3.y}; f1 = f.v;
    f.u = (u32x4){r4.x, r4.y, r5.x, r5.y}; f2 = f.v; f.u = (u32x4){r6.x, r6.y, r7.x, r7.y}; f3 = f.v;
}

__device__ __forceinline__ void ret_scan(const int wv, bf16_t* __restrict__ kv) {
    int ts_ = TIDX; asm volatile("" : "+v"(ts_));
    for (int idx = blockIdx.x * 512 + ts_; idx < 4 * 32768; idx += gridDim.x * 512) {
        const int h = idx >> 15, e4 = idx & 32767;
        const float gC = exp2f(128.0f * log2f(1.0f - exp2f(-5.0f - (float)h)));
        bf16_t* pbase = kv + (size_t)h * 64 * 131072 + (size_t)e4 * 4;
        float s0 = 0.f, s1 = 0.f, s2 = 0.f, s3 = 0.f;
#pragma unroll 1
        for (int n0 = 0; n0 < 64; n0 += 8) {
            u32x2 v[8];
#pragma unroll
            for (int k = 0; k < 8; ++k) v[k] = *(const u32x2*)(pbase + (size_t)(n0 + k) * 131072);
#pragma unroll
            for (int k = 0; k < 8; ++k) {
                u32x2 o; o.x = cvt_pk_bf16(s0, s1); o.y = cvt_pk_bf16(s2, s3);
                *(u32x2*)(pbase + (size_t)(n0 + k) * 131072) = o;
                s0 = (s0 + bflo(v[k].x)) * gC; s1 = (s1 + bfhi(v[k].x)) * gC; s2 = (s2 + bflo(v[k].y)) * gC; s3 = (s3 + bfhi(v[k].y)) * gC;
            }
        }
    }
}

__device__ __forceinline__ void retc_stream(const int wv, LAS unsigned char* lds, unsigned ldsb, const float* __restrict__ gn_g, const float* __restrict__ gn_b, const bf16_t* __restrict__ qkvr, const bf16_t* __restrict__ grb, const bf16_t* __restrict__ kv,
                                            bf16_t* __restrict__ orb  , int first, int stride, int count) {
    int t_ = TIDX; asm volatile("" : "+v"(t_));
    const int t = t_, w = __builtin_amdgcn_readfirstlane(t >> 6), lane = t & 63, li = lane & 15, g = lane >> 4;
    if (first >= count) return;
    const size_t RS = (size_t)QKVR_LD * 2;
    const unsigned rsub = (unsigned)w * 2u + ((unsigned)lane >> 5), cc = ((unsigned)lane & 31u) ^ rsub;
    const size_t goffA = (size_t)rsub * RS + cc * 16;
    const size_t goffS = (size_t)rsub * 512 + cc * 16;
    const int q4 = li >> 2, p4 = lane & 3;
#define RETC_ISSUE(item_, s_) do { const int h_ = (item_) >> 6, n_ = (item_) & 63; const unsigned img_ = ((s_) & 1) * 65536u; \
        if ((s_) < 4) { const int col_ = (s_) == 0 ? C_RQ + h_ * 256 : ((s_) == 1 ? C_RK + h_ * 256 : C_RV + h_ * 512 + ((s_) - 2) * 256); \
            const char* gb_ = (const char*)(qkvr + (size_t)(n_ * 128) * QKVR_LD + col_) + goffA; \
            _Pragma("unroll") for (int i_ = 0; i_ < 8; ++i_) DMA16(gb_ + (size_t)i_ * 16 * RS, lds + img_ + i_ * 8192 + w * 1024); } \
        else { const char* gb_ = (const char*)(kv + ((size_t)(h_ * 64 + n_) * 512 + ((s_) - 4) * 128) * 256) + goffS; \
            _Pragma("unroll") for (int i_ = 0; i_ < 8; ++i_) DMA16(gb_ + (size_t)i_ * 16 * 512, lds + img_ + i_ * 8192 + w * 1024); } } while (0)
    unsigned koff[8], toff[8];
#pragma unroll
    for (int s = 0; s < 8; ++s) { koff[s] = (unsigned)li * 512u + ((((unsigned)(4 * s + g)) ^ (unsigned)li) << 4); asm volatile("" : "+v"(koff[s])); }
    { const unsigned xx = (unsigned)(4 * g + q4) & 15u, ph = (unsigned)p4 >> 1, rb = (unsigned)(4 * g + q4) * 512u + 8u * ((unsigned)p4 & 1u);
#pragma unroll
      for (int c = 0; c < 8; ++c) { toff[c] = rb + (((2u * c + ph) ^ xx) << 4); asm volatile("" : "+v"(toff[c])); } }
    int item = first;
    RETC_ISSUE(item, 0);
    for (;;) {
        const int h = item >> 6, n = item & 63;
        const int inext = item + stride;
        const float lg2 = log2f(1.0f - exp2f(-5.0f - (float)h));
        WAITV0(); LBAR(); RETC_ISSUE(item, 1);
        bf16x8 qf[8];
        { unsigned ib = (unsigned)w * 8192u; asm volatile("" : "+v"(ib));
#pragma unroll
        for (int s = 0; s < 8; ++s) qf[s] = *(const LAS bf16x8*)(lds + ib + koff[s]); }
        WAITV0(); LBAR(); RETC_ISSUE(item, 2);
        bf16x8 pf[4];
        {
            f32x4 sc[8];
            const int qi = 16 * w + li;
            unsigned ibk = 65536u; asm volatile("" : "+v"(ibk));
#pragma unroll
            for (int kt = 0; kt < 8; ++kt) {
                f32x4 a = (f32x4){0.f, 0.f, 0.f, 0.f};
                if (kt <= w) {
                    bf16x8 kf[8];
#pragma unroll
                    for (int s = 0; s < 8; ++s) kf[s] = *(const LAS bf16x8*)(lds + ibk + kt * 8192 + koff[s]);
                    asm volatile("s_waitcnt lgkmcnt(0)" ::: "memory");
#pragma unroll
                    for (int s = 0; s < 8; ++s) a = MFMA16(kf[s], qf[s], a);
                }
#pragma unroll
                for (int e = 0; e < 4; ++e) { const int kj = 16 * kt + 4 * g + e; a[e] = (kj <= qi) ? a[e] : 0.f; }
                sc[kt] = a;
            }
#pragma unroll
            for (int u = 0; u < 4; ++u) { Frag f; f.u.x = cvt_pk_bf16(sc[2 * u][0], sc[2 * u][1]); f.u.y = cvt_pk_bf16(sc[2 * u][2], sc[2 * u][3]); f.u.z = cvt_pk_bf16(sc[2 * u + 1][0], sc[2 * u + 1][1]); f.u.w = cvt_pk_bf16(sc[2 * u + 1][2], sc[2 * u + 1][3]); pf[u] = f.v; }
        }
        f32x4 acc[32];
#pragma unroll
        for (int c = 0; c < 32; ++c) acc[c] = (f32x4){0.f, 0.f, 0.f, 0.f};
#pragma unroll
        for (int vh = 0; vh < 2; ++vh) {
            WAITV0(); LBAR(); RETC_ISSUE(item, 3 + vh);
            unsigned imgb = ldsb + vh * 65536u; asm volatile("" : "+v"(imgb));
#pragma unroll
            for (int u = 0; u < 4; ++u) {
                if (2 * u <= w) {
                    const unsigned a0 = imgb + u * 16384u, a1 = a0 + 8192u;
#pragma unroll
                    for (int c = 0; c < 16; c += 4) {
                        bf16x8 v0, v1, v2, v3;
                        const unsigned hi = (c >> 3) * 256u;
                        tr_frag4x(a0 + hi + toff[c & 7], a1 + hi + toff[c & 7], a0 + hi + toff[(c & 7) + 1], a1 + hi + toff[(c & 7) + 1],
                                  a0 + hi + toff[(c & 7) + 2], a1 + hi + toff[(c & 7) + 2], a0 + hi + toff[(c & 7) + 3], a1 + hi + toff[(c & 7) + 3], v0, v1, v2, v3);
                        acc[vh * 16 + c] = MFMA16(pf[u], v0, acc[vh * 16 + c]); acc[vh * 16 + c + 1] = MFMA16(pf[u], v1, acc[vh * 16 + c + 1]);
                        acc[vh * 16 + c + 2] = MFMA16(pf[u], v2, acc[vh * 16 + c + 2]); acc[vh * 16 + c + 3] = MFMA16(pf[u], v3, acc[vh * 16 + c + 3]);
                    }
                }
            }
        }
#pragma unroll
        for (int vc = 0; vc < 4; ++vc) {
            WAITV0(); LBAR();
            if (vc < 3) RETC_ISSUE(item, 5 + vc);
            unsigned img = (vc & 1) * 65536u; asm volatile("" : "+v"(img));
#pragma unroll
            for (int s = 0; s < 8; ++s) {
                bf16x8 bfr[8];
#pragma unroll
                for (int c = 0; c < 8; ++c) bfr[c] = *(const LAS bf16x8*)(lds + img + c * 8192 + koff[s]);
                asm volatile("s_waitcnt lgkmcnt(0)" ::: "memory");
#pragma unroll
                for (int c = 0; c < 8; ++c) acc[vc * 8 + c] = MFMA16(qf[s], bfr[c], acc[vc * 8 + c]);
            }
        }
        const float* gng = gn_g + h * 512; const float* gnb = gn_b + h * 512;
        float mu4[4], rs4[4];
#pragma unroll
        for (int e = 0; e < 4; ++e) {
            const int q = 16 * w + 4 * g + e;
            const float xi = exp2f(lg2 * (float)(q - 127));
            float sum = 0.f;
#pragma unroll
            for (int c = 0; c < 32; ++c) { acc[c][e] *= xi; sum += acc[c][e]; }
            sum += shx(sum, lane, 1); sum += shx(sum, lane, 2); sum += shx(sum, lane, 4); sum += shx(sum, lane, 8);
            const float mu = sum * (1.0f / 512.0f);
            float var = 0.f;
#pragma unroll
            for (int c = 0; c < 32; ++c) { const float d = acc[c][e] - mu; var += d * d; }
            var += shx(var, lane, 1); var += shx(var, lane, 2); var += shx(var, lane, 4); var += shx(var, lane, 8);
            mu4[e] = mu; rs4[e] = rsqrtf(var * (1.0f / 512.0f) + EPS);
        }
        LBAR();
        {
            unsigned wb = (unsigned)(16 * w + 4 * g) * 1024u + (unsigned)li * 2u; asm volatile("" : "+v"(wb));
#pragma unroll
            for (int c = 0; c < 32; ++c) {
                const unsigned co = (unsigned)(((2 * c) ^ (2 * g)) * 16);
#pragma unroll
                for (int e = 0; e < 4; ++e)
                    *(LAS bf16_t*)(lds + wb + e * 1024 + co) = f2bf((acc[c][e] - mu4[e]) * rs4[e]);
            }
        }
        {
            int tq = t; asm volatile("" : "+v"(tq));
            const int ch = tq & 63, r0 = tq >> 6;
            const f32x4 g0 = *(const f32x4*)(gng + ch * 8), g1 = *(const f32x4*)(gng + ch * 8 + 4), b0 = *(const f32x4*)(gnb + ch * 8), b1 = *(const f32x4*)(gnb + ch * 8 + 4);
            u32x4 gv[16];
#pragma unroll
            for (int k = 0; k < 16; ++k) gv[k] = *(const u32x4*)(grb + (size_t)(n * 128 + r0 + 8 * k) * 2048 + h * 512 + ch * 8);
            LBAR();
#pragma unroll
            for (int k = 0; k < 16; ++k) {
                const int row = r0 + 8 * k;
                const u32x4 yv = *(const LAS u32x4*)(lds + row * 1024 + ((ch ^ (2 * ((row >> 2) & 3))) << 4));
                const u32x4 q = gv[k];
                u32x4 o;
                o.x = cvt_pk_bf16((bflo(yv.x) * g0[0] + b0[0]) * bflo(q.x), (bfhi(yv.x) * g0[1] + b0[1]) * bfhi(q.x));
                o.y = cvt_pk_bf16((bflo(yv.y) * g0[2] + b0[2]) * bflo(q.y), (bfhi(yv.y) * g0[3] + b0[3]) * bfhi(q.y));
                o.z = cvt_pk_bf16((bflo(yv.z) * g1[0] + b1[0]) * bflo(q.z), (bfhi(yv.z) * g1[1] + b1[1]) * bfhi(q.z));
                o.w = cvt_pk_bf16((bflo(yv.w) * g1[2] + b1[2]) * bflo(q.w), (bfhi(yv.w) * g1[3] + b1[3]) * bfhi(q.w));
                *(u32x4*)(orb + (size_t)(n * 128 + row) * 2048 + h * 512 + ch * 8) = o;
            }
        }
        if (inext >= count) break;
        LBAR();
        RETC_ISSUE(inext, 0);
        item = inext;
    }
#undef RETC_ISSUE
    WAITV0(); LBAR();
}

__device__ __forceinline__ void reta_item(const int wv, LAS unsigned char* lds, unsigned ldsb, const bf16_t* __restrict__ qkvr, bf16_t* __restrict__ kv, int j) {
    const int h = j >> 7, n = (j >> 1) & 63, vh = j & 1;
    int t_ = TIDX; asm volatile("" : "+v"(t_));
    const int t = t_, w = __builtin_amdgcn_readfirstlane(t >> 6), lane = t & 63, li = lane & 15, g = lane >> 4;
    const unsigned VI = 0, KI = 128 * PR;
    const float lg2 = log2f(1.0f - exp2f(-5.0f - (float)h));
    {
        const int c = t & 31, rr = t >> 5;
#pragma unroll
        for (int it = 0; it < 8; ++it) {
            const int row = rr + 16 * it; const size_t tokoff = (size_t)(n * 128 + row) * QKVR_LD;
            const u32x4 kvv = *(const u32x4*)(qkvr + tokoff + C_RK + h * 256 + c * 8);
            *(LAS u32x4*)(lds + KI + row * PR + c * 16) = kvv;
            const u32x4 v = *(const u32x4*)(qkvr + tokoff + C_RV + h * 512 + vh * 256 + c * 8);
            const float z = 1.0f;
            u32x4 o; o.x = cvt_pk_bf16(bflo(v.x) * z, bfhi(v.x) * z); o.y = cvt_pk_bf16(bflo(v.y) * z, bfhi(v.y) * z);
            o.z = cvt_pk_bf16(bflo(v.z) * z, bfhi(v.z) * z); o.w = cvt_pk_bf16(bflo(v.w) * z, bfhi(v.w) * z);
            *(LAS u32x4*)(lds + VI + row * PR + c * 16) = o;
        }
    }
    __syncthreads();
    const int wm = w >> 1, wn = w & 1;
    const int q4 = (lane & 15) >> 2, p4 = lane & 3;
    f32x4 acc[4][8];
#pragma unroll
    for (int mi = 0; mi < 4; ++mi)
#pragma unroll
        for (int ci = 0; ci < 8; ++ci) acc[mi][ci] = (f32x4){0.f, 0.f, 0.f, 0.f};
#pragma unroll 1
    for (int ks = 0; ks < 4; ++ks) {
        const unsigned r0 = (32 * ks + 8 * g + q4) * PR + 8 * p4, r1 = r0 + 4 * PR;
        bf16x8 af[4];
        tr_frag4(ldsb + KI + r0 + 128 * wm, ldsb + KI + r1 + 128 * wm, 0u, 32u, 64u, 96u, af[0], af[1], af[2], af[3]);
#pragma unroll
        for (int ci = 0; ci < 8; ci += 4) {
            bf16x8 b0, b1, b2, b3;
            tr_frag4(ldsb + VI + r0 + 256 * wn, ldsb + VI + r1 + 256 * wn, 32u * ci, 32u * (ci + 1), 32u * (ci + 2), 32u * (ci + 3), b0, b1, b2, b3);
#pragma unroll
            for (int mi = 0; mi < 4; ++mi) {
                acc[mi][ci] = MFMA16(af[mi], b0, acc[mi][ci]); acc[mi][ci + 1] = MFMA16(af[mi], b1, acc[mi][ci + 1]);
                acc[mi][ci + 2] = MFMA16(af[mi], b2, acc[mi][ci + 2]); acc[mi][ci + 3] = MFMA16(af[mi], b3, acc[mi][ci + 3]);
            }
        }
    }
    bf16_t* base = kv + ((size_t)(h * 64 + n) * 512 + vh * 256) * 256;
    __syncthreads();
#pragma unroll
    for (int mi = 0; mi < 4; ++mi)
#pragma unroll
        for (int ci = 0; ci < 8; ++ci) {
            u32x2 o; o.x = cvt_pk_bf16(acc[mi][ci][0], acc[mi][ci][1]); o.y = cvt_pk_bf16(acc[mi][ci][2], acc[mi][ci][3]);
            *(LAS u32x2*)(lds + (128 * wn + 16 * ci + li) * PR + (64 * wm + 16 * mi + 4 * g) * 2) = o;
        }
    __syncthreads();
#pragma unroll 4
    for (int k = 0; k < 16; ++k) {
        const int id = t + 512 * k, row = id >> 5, ch = id & 31;
        *(u32x4*)(base + (size_t)row * 256 + ch * 8) = *(const LAS u32x4*)(lds + row * PR + ch * 16);
    }
    __syncthreads();
}

__device__ __forceinline__ void attn_combine(const int wv, const bf16_t* __restrict__ og, const float* __restrict__ lse, bf16_t* __restrict__ oa  ) {
    int tc_ = TIDX; asm volatile("" : "+v"(tc_));
    const int stride = gridDim.x * 512;
    for (int idx0 = blockIdx.x * 512 + tc_; idx0 < TB * 64; idx0 += 4 * stride) {
        float l[4][3]; u32x4 v[4][3];
#pragma unroll
        for (int q = 0; q < 4; ++q) {
            const int idx = idx0 + q * stride;
            if (idx < TB * 64) {
                const int tok = idx >> 6, hs = (idx >> 4) & 3, c = idx & 15;
#pragma unroll
                for (int gi = 0; gi < 3; ++gi) { l[q][gi] = lse[tok * 12 + 4 * gi + hs]; v[q][gi] = *(const u32x4*)(og + (size_t)tok * 1536 + (4 * gi + hs) * 128 + c * 8); }
            }
        }
#pragma unroll
        for (int q = 0; q < 4; ++q) {
            const int idx = idx0 + q * stride;
            if (idx < TB * 64) {
                const int tok = idx >> 6, hs = (idx >> 4) & 3, c = idx & 15;
                const float m = fmaxf(l[q][0], fmaxf(l[q][1], l[q][2]));
                float a0 = __expf(l[q][0] - m), a1 = __expf(l[q][1] - m), a2 = __expf(l[q][2] - m);
                const float inv = __builtin_amdgcn_rcpf(a0 + a1 + a2); a0 *= inv; a1 *= inv; a2 *= inv;
                const u32x4 v0 = v[q][0], v1 = v[q][1], v2 = v[q][2];
                u32x4 o;
                o.x = cvt_pk_bf16(a0 * bflo(v0.x) + a1 * bflo(v1.x) + a2 * bflo(v2.x), a0 * bfhi(v0.x) + a1 * bfhi(v1.x) + a2 * bfhi(v2.x));
                o.y = cvt_pk_bf16(a0 * bflo(v0.y) + a1 * bflo(v1.y) + a2 * bflo(v2.y), a0 * bfhi(v0.y) + a1 * bfhi(v1.y) + a2 * bfhi(v2.y));
                o.z = cvt_pk_bf16(a0 * bflo(v0.z) + a1 * bflo(v1.z) + a2 * bflo(v2.z), a0 * bfhi(v0.z) + a1 * bfhi(v1.z) + a2 * bfhi(v2.z));
                o.w = cvt_pk_bf16(a0 * bflo(v0.w) + a1 * bflo(v1.w) + a2 * bflo(v2.w), a0 * bfhi(v0.w) + a1 * bfhi(v1.w) + a2 * bfhi(v2.w));
                *(u32x4*)(oa + (size_t)tok * 512 + hs * 128 + c * 8) = o;
            }
        }
    }
}


#define XB_TMO      128
#define XB_XCNT(j)  (256  + 64 * (j))
#define XB_XSUB(j)  (1280 + 64 * (j))
#define XB_XGEN(j)  (2304 + 64 * (j))
#define XB_TOP      3328
#define XB_TOPGEN   3392
#define XCD_BAR_WORDS 3456
#define XB_SPIN_CAP (1u << 22)
__device__ __forceinline__ unsigned xb_ld(unsigned* p)              { return __hip_atomic_load(p, __ATOMIC_RELAXED, __HIP_MEMORY_SCOPE_AGENT); }
__device__ __forceinline__ unsigned xb_add(unsigned* p, unsigned v) { return __hip_atomic_fetch_add(p, v, __ATOMIC_RELAXED, __HIP_MEMORY_SCOPE_AGENT); }
__device__ __forceinline__ unsigned xb_xcc_id() { return (unsigned)__builtin_amdgcn_s_getreg((3 << 11) | 20) & 0xFu; }
#define XB_SPIN(cond, bar) do { unsigned _sp = 0; while (cond) { __builtin_amdgcn_s_sleep(1); \
    if ((++_sp & 255u) == 0u) { if (xb_ld(&(bar)[XB_TMO])) break; if (_sp > XB_SPIN_CAP) { atomicAdd(&(bar)[XB_TMO], 1u); break; } } } } while (0)
struct XcdBarrier { unsigned* bar; unsigned x; volatile LAS unsigned* st; };
__device__ __forceinline__ XcdBarrier xcd_barrier_post(const int wv, unsigned* bar, volatile LAS unsigned* st) {
    XcdBarrier b; b.bar = bar; b.x = xb_xcc_id(); b.st = st;
    if (TIDX == 0) (void)xb_add(&bar[XB_XCNT(b.x)], 1u);
    return b;
}
__device__ __forceinline__ void xcd_barrier_complete(unsigned* bar, unsigned x, unsigned& nloc, unsigned& nx) {
    const unsigned G = gridDim.x * gridDim.y * gridDim.z;
    unsigned sum, cnt, mine, sp = 0u;
    for (;;) {
        sum = 0u; cnt = 0u; mine = 0u;
#pragma unroll
        for (unsigned j = 0; j < 16; ++j) { const unsigned c = xb_ld(&bar[XB_XCNT(j)]); sum += c; cnt += (c > 0u) ? 1u : 0u; mine = (j == x) ? c : mine; }
        if (sum == G) break;
        __builtin_amdgcn_s_sleep(1);
        if ((++sp & 255u) == 0u) { if (xb_ld(&bar[XB_TMO])) break; if (sp > XB_SPIN_CAP) { atomicAdd(&bar[XB_TMO], 1u); break; } }
    }
    nloc = mine > 0u ? mine : 1u; nx = cnt > 0u ? cnt : 1u;
}
__device__ __forceinline__ void xcd_barrier(const int wv, const XcdBarrier& b) {
    asm volatile("s_waitcnt vmcnt(0)" ::: "memory");
    __syncthreads();
    if (TIDX == 0) {
        unsigned long long barq = (unsigned long long)b.bar; asm volatile("" : "+s"(barq));
        unsigned* bar = (unsigned*)barq;
        __builtin_amdgcn_s_waitcnt(0);
        unsigned nloc = b.st[0], nx = b.st[1];
        if (nloc == 0u) { xcd_barrier_complete(bar, b.x, nloc, nx); b.st[0] = nloc; b.st[1] = nx; }
        const unsigned old = xb_add(&bar[XB_XSUB(b.x)], 1u);
        const unsigned gen = old / nloc;
        if (old + 1u == (gen + 1u) * nloc) {
            __builtin_amdgcn_fence(__ATOMIC_RELEASE, "agent");
            asm volatile("s_waitcnt vmcnt(0)" ::: "memory");
            const unsigned og = xb_add(&bar[XB_TOP], 1u);
            const unsigned tg = og / nx;
            if (og + 1u == (tg + 1u) * nx) xb_add(&bar[XB_TOPGEN], 1u);
            else XB_SPIN(xb_ld(&bar[XB_TOPGEN]) == tg, bar);
            __builtin_amdgcn_fence(__ATOMIC_ACQUIRE, "agent");
            xb_add(&bar[XB_XGEN(b.x)], 1u);
            asm volatile("s_waitcnt vmcnt(0)" ::: "memory");
        } else {
            XB_SPIN(xb_ld(&bar[XB_XGEN(b.x)]) == gen, bar);
            __builtin_amdgcn_fence(__ATOMIC_ACQUIRE, "agent");
            asm volatile("s_waitcnt vmcnt(0)" ::: "memory");
        }
    }
    __syncthreads();
}

typedef const __attribute__((address_space(4))) Params* KParams;
__device__ __forceinline__ KParams kparams() { unsigned long long a = (unsigned long long)__builtin_amdgcn_kernarg_segment_ptr(); asm volatile("" : "+s"(a)); return (KParams)a; }

__global__ void __launch_bounds__(512, 2) mega(Params p_unused) {
    extern __shared__ __attribute__((aligned(16))) unsigned char shm[];
    LAS unsigned char* lds = (LAS unsigned char*)shm;
    const unsigned ldsb = (unsigned)(size_t)lds;
    const int wv = __builtin_amdgcn_readfirstlane((int)(threadIdx.x >> 6));
    cg::grid_group grid = cg::this_grid();
    volatile LAS unsigned* xst = (volatile LAS unsigned*)(lds + LDS_BYTES - 16);
    if (TIDX == 0) { xst[0] = 0u; xst[1] = 0u; }
    __syncthreads();
    const XcdBarrier xb = xcd_barrier_post(wv, (unsigned*)(kparams()->ws + WS_BAR), xst);
#define GSYNC() xcd_barrier(wv, xb)
#define WSP(T, off) ((T*)(ws + (off)))

    {
        KParams kp = kparams(); unsigned char* ws = kp->ws;
        transpose_w(wv, lds, kp->w_in, WSP(bf16_t, WS_WIN), DM, INW, kp->norm1_g, C_RK, C_RK + 1024, 0.0625f);
        transpose_w(wv, lds, kp->w_pa, WSP(bf16_t, WS_WPA), 512, DM, nullptr, 0, 0, 1.f);
        transpose_w(wv, lds, kp->w_pb, WSP(bf16_t, WS_WPB), 2048, DM, nullptr, 0, 0, 1.f);
        transpose_w(wv, lds, kp->w_out, WSP(bf16_t, WS_WOUT), DM, DM, nullptr, 0, 0, 1.f);
        transpose_w(wv, lds, kp->w_up, WSP(bf16_t, WS_WUP), DM, DFF, kp->norm2_g, 0, 0, 1.f);
        transpose_w(wv, lds, kp->w_dn, WSP(bf16_t, WS_WDN), DFF, DM, nullptr, 0, 0, 1.f);
        prep_x(wv, kp->x, WSP(bf16_t, WS_OR));
    }
    if (kparams()->ws == nullptr) grid.sync();
    GSYNC();

    for (int b = 0; b < 4; ++b) {
        {
            KParams kp = kparams(); unsigned char* ws = kp->ws;
            pg8::Gemm gm{WSP(bf16_t, WS_OR) + (size_t)b * TB * 2048, WSP(bf16_t, WS_WIN), TB, INW, DM, DM, DM};
            InProjOrder S; S.init(b, (int)gridDim.x, (int)blockIdx.x);
            EpiIn E{WSP(bf16_t, WS_R0), WSP(bf16_t, WS_GR), (bf16_t*)kp->out + (size_t)b * TB * 2048};
            pg8::gemm_phase<EpiIn, InProjOrder>(wv, lds, gm, S, E);
        }
        GSYNC();
        {
            KParams kp = kparams(); unsigned char* ws = kp->ws;
            attn_stream(wv, lds, ldsb, kp->q_norm_g, kp->k_norm_g, WSP(bf16_t, WS_R0), WSP(bf16_t, WS_OG), WSP(float, WS_LSE), (int)blockIdx.x, (int)gridDim.x, 768);
        }
        {
            KParams kp = kparams(); unsigned char* ws = kp->ws;
            for (int j = blockIdx.x; j < 512; j += gridDim.x) reta_item(wv, lds, ldsb, WSP(bf16_t, WS_R0), WSP(bf16_t, WS_KV), j);
        }
        GSYNC();
        { KParams kp = kparams(); unsigned char* ws = kp->ws; ret_scan(wv, WSP(bf16_t, WS_KV)); }
        GSYNC();
        {
            KParams kp = kparams(); unsigned char* ws = kp->ws;
            retc_stream(wv, lds, ldsb, kp->gn_g, kp->gn_b, WSP(bf16_t, WS_R0), WSP(bf16_t, WS_GR), WSP(bf16_t, WS_KV), WSP(bf16_t, WS_OR) + (size_t)b * TB * 2048, (int)blockIdx.x, (int)gridDim.x, 256);
        }
        {
            KParams kp = kparams(); unsigned char* ws = kp->ws;
            attn_combine(wv, WSP(bf16_t, WS_OG), WSP(float, WS_LSE), WSP(bf16_t, WS_OA) + (size_t)b * TB * 512);
        }
        GSYNC();
    }
    {
        KParams kp = kparams(); unsigned char* ws = kp->ws;
        pg8::StaticOrder S; S.init(MT, DM, (int)gridDim.x, (int)blockIdx.x);
        { pg8::Gemm gm{WSP(bf16_t, WS_OA), WSP(bf16_t, WS_WPA), MT, DM, 512, 512, 512}; EpiGate<0> E{(const bf16_t*)kp->out, WSP(bf16_t, WS_Y)}; pg8::gemm_phase<EpiGate<0>, pg8::StaticOrder>(wv, lds, gm, S, E); }
        { pg8::Gemm gm{WSP(bf16_t, WS_OR), WSP(bf16_t, WS_WPB), MT, DM, 2048, 2048, 2048}; EpiGate<1> E{(const bf16_t*)kp->out, WSP(bf16_t, WS_Y)}; pg8::gemm_phase<EpiGate<1>, pg8::StaticOrder>(wv, lds, gm, S, E); }
    }
    GSYNC();
    {
        KParams kp = kparams(); unsigned char* ws = kp->ws;
        pg8::StaticOrder S; S.init(MT, DM, (int)gridDim.x, (int)blockIdx.x);
        pg8::Gemm gm{WSP(bf16_t, WS_Y), WSP(bf16_t, WS_WOUT), MT, DM, DM, DM, DM}; EpiOut E{kp->x, WSP(bf16_t, WS_X1B), WSP(float, WS_SS2)};
        pg8::gemm_phase<EpiOut, pg8::StaticOrder>(wv, lds, gm, S, E);
    }
    GSYNC();
    {
        KParams kp = kparams(); unsigned char* ws = kp->ws;
        pg8::StaticOrder S; S.init(MT, DFF, (int)gridDim.x, (int)blockIdx.x);
        pg8::Gemm gm{WSP(bf16_t, WS_X1B), WSP(bf16_t, WS_WUP), MT, DFF, DM, DM, DM}; EpiUp E{WSP(float, WS_SS2), WSP(bf16_t, WS_H)};
        pg8::gemm_phase<EpiUp, pg8::StaticOrder>(wv, lds, gm, S, E);
    }
    GSYNC();
    {
        KParams kp = kparams(); unsigned char* ws = kp->ws;
        pg8::StaticOrder S; S.init(MT, DM, (int)gridDim.x, (int)blockIdx.x);
        pg8::Gemm gm{WSP(bf16_t, WS_H), WSP(bf16_t, WS_WDN), MT, DM, DFF, DFF, DFF, 1}; EpiDown E{WSP(bf16_t, WS_X1B), kp->out};
        pg8::gemm_phase<EpiDown, pg8::StaticOrder>(wv, lds, gm, S, E);
    }
}

extern "C" void kernel_launch(void* const* d_in, const int* in_sizes, int n_in, void* d_out, int out_size, void* d_ws, size_t ws_size, hipStream_t stream) {
    static int grid_blocks = 0;
    if (grid_blocks == 0) {
        if (ws_size < WS_END) { fprintf(stderr, "kernel_launch: workspace too small: %zu < %zu\n", ws_size, (size_t)WS_END); grid_blocks = -1; return; }
        int dev = 0, cus = 0, per_cu = 0;
        hipGetDevice(&dev);
        hipDeviceGetAttribute(&cus, hipDeviceAttributeMultiprocessorCount, dev);
        if (hipFuncSetAttribute((const void*)mega, hipFuncAttributeMaxDynamicSharedMemorySize, LDS_BYTES) != hipSuccess) { fprintf(stderr, "kernel_launch: hipFuncSetAttribute failed\n"); grid_blocks = -1; return; }
        if (hipOccupancyMaxActiveBlocksPerMultiprocessor(&per_cu, (const void*)mega, 512, LDS_BYTES) != hipSuccess || per_cu < 1) { fprintf(stderr, "kernel_launch: occupancy query failed (%d)\n", per_cu); per_cu = 1; (void)hipGetLastError(); }
        grid_blocks = cus * per_cu;
    }
    if (grid_blocks < 0) return;
    Params p{};
    p.x = (const float*)d_in[0]; p.norm1_g = (const float*)d_in[1]; p.w_in = (const float*)d_in[2]; p.q_norm_g = (const float*)d_in[3]; p.k_norm_g = (const float*)d_in[4];
    p.gn_g = (const float*)d_in[5]; p.gn_b = (const float*)d_in[6]; p.w_pa = (const float*)d_in[7]; p.w_pb = (const float*)d_in[8]; p.w_out = (const float*)d_in[9];
    p.norm2_g = (const float*)d_in[10]; p.w_up = (const float*)d_in[11]; p.w_dn = (const float*)d_in[12];
    p.out = (float*)d_out; p.ws = (unsigned char*)d_ws;
    if (hipMemsetAsync((char*)d_ws + WS_BAR, 0, XCD_BAR_WORDS * 4, stream) != hipSuccess) { fprintf(stderr, "kernel_launch: memset failed\n"); return; }
    void* args[] = {&p};
    hipError_t e = hipLaunchCooperativeKernel((const void*)mega, dim3(grid_blocks), dim3(512), args, LDS_BYTES, stream);
    if (e != hipSuccess) fprintf(stderr, "cooperative launch failed: %s (grid %d)\n", hipGetErrorString(e), grid_blocks);
}
```

```cpp
#include <hip/hip_runtime.h>
#include <hip/hip_cooperative_groups.h>
#include <cstdio>
#ifndef REP_A
#define REP_A 1
#endif
#ifndef REP_B1
#define REP_B1 1
#endif
#ifndef REP_B3
#define REP_B3 1
#endif
#ifndef REP_SYNC
#define REP_SYNC 1
#endif
namespace cg = cooperative_groups;

#define LAS __attribute__((address_space(3)))
typedef unsigned short bf16_t;
typedef short bf16x8 __attribute__((ext_vector_type(8)));
typedef float f32x4 __attribute__((ext_vector_type(4)));
typedef unsigned u32x4 __attribute__((ext_vector_type(4)));
typedef unsigned u32x2 __attribute__((ext_vector_type(2)));

constexpr int MT = 32768, TB = 8192, DM = 1024, INW = 12800, DFF = 4096;
constexpr int QKVR_LD = 8704;
constexpr int C_AQ = 0, C_AK = 1536, C_AV = 3072, C_RQ = 4608, C_RK = 5632, C_RV = 6656;
constexpr float EPS = 1e-6f;
constexpr int LDS_BYTES = 139264;
constexpr int PA = 272;
constexpr int PR = 528;

constexpr size_t MiB = 1024 * 1024;
constexpr size_t WS_WIN = 0;
constexpr size_t WS_WPA = WS_WIN + 25 * MiB;
constexpr size_t WS_WPB = WS_WPA + 1 * MiB;
constexpr size_t WS_WOUT = WS_WPB + 4 * MiB;
constexpr size_t WS_WUP = WS_WOUT + 2 * MiB;
constexpr size_t WS_WDN = WS_WUP + 8 * MiB;
constexpr size_t WS_RSTD1 = WS_WDN + 8 * MiB;
constexpr size_t WS_BAR = WS_RSTD1 + 512 * 1024;
constexpr size_t WS_SS2 = WS_RSTD1 + 1 * MiB;
constexpr size_t WS_LSE = WS_SS2 + 2 * MiB;
constexpr size_t WS_OG = WS_LSE + 1 * MiB;
constexpr size_t WS_KV = WS_OG + 24 * MiB;
constexpr size_t WS_R0 = WS_KV + 64 * MiB;
constexpr size_t WS_GR = WS_R0 + 136 * MiB;
constexpr size_t WS_R1 = WS_R0 + 168 * MiB;
constexpr size_t WS_OA = WS_R1;
constexpr size_t WS_OR = WS_R1 + 32 * MiB;
constexpr size_t WS_END = WS_R1 + 160 * MiB;
constexpr size_t WS_X1B = WS_R0;
constexpr size_t WS_Y = WS_R0 + 64 * MiB;
constexpr size_t WS_H = WS_R0 + 64 * MiB;

struct Params {
    const float* x; const float* norm1_g; const float* w_in; const float* q_norm_g; const float* k_norm_g;
    const float* gn_g; const float* gn_b; const float* w_pa; const float* w_pb; const float* w_out;
    const float* norm2_g; const float* w_up; const float* w_dn;
    float* out; unsigned char* ws;
};

__device__ __forceinline__ int lane_id_() { int l; asm volatile("v_mbcnt_lo_u32_b32 %0, -1, 0\n\tv_mbcnt_hi_u32_b32 %0, -1, %0" : "=v"(l)); return l; }
#define TIDX (wv * 64 + lane_id_())
__device__ __forceinline__ float shx(float v, int lane, int mask) { return __int_as_float(__builtin_amdgcn_ds_bpermute((lane ^ mask) << 2, __float_as_int(v))); }
__device__ __forceinline__ float shl(float v, int src) { return __int_as_float(__builtin_amdgcn_ds_bpermute(src << 2, __float_as_int(v))); }
__device__ __forceinline__ unsigned cvt_pk_bf16(float lo, float hi) { unsigned r; asm volatile("v_cvt_pk_bf16_f32 %0, %1, %2" : "=v"(r) : "v"(lo), "v"(hi)); return r; }
__device__ __forceinline__ float bflo(unsigned u) { return __uint_as_float(u << 16); }
__device__ __forceinline__ float bfhi(unsigned u) { return __uint_as_float(u & 0xffff0000u); }
__device__ __forceinline__ float bf2f(bf16_t b) { return __uint_as_float(((unsigned)b) << 16); }
__device__ __forceinline__ bf16_t f2bf(float f) { return (bf16_t)(cvt_pk_bf16(f, 0.f) & 0xffffu); }
__device__ __forceinline__ float sigmoidf_(float v) { return __builtin_amdgcn_rcpf(1.0f + __expf(-v)); }
union Frag { bf16x8 v; u32x4 u; };

__device__ __forceinline__ bf16x8 tr_frag(unsigned a0, unsigned a1) {
    u32x2 r0, r1;
    asm volatile("ds_read_b64_tr_b16 %0, %2\n\tds_read_b64_tr_b16 %1, %3\n\ts_waitcnt lgkmcnt(0)" : "=&v"(r0), "=&v"(r1) : "v"(a0), "v"(a1) : "memory");
    Frag f; f.u = (u32x4){r0.x, r0.y, r1.x, r1.y}; return f.v;
}
__device__ __forceinline__ void tr_frag4(unsigned a0, unsigned a1, unsigned d0, unsigned d1, unsigned d2, unsigned d3, bf16x8& f0, bf16x8& f1, bf16x8& f2, bf16x8& f3) {
    u32x2 r0, r1, r2, r3, r4, r5, r6, r7;
    const unsigned x0 = a0 + d0, y0 = a1 + d0, x1 = a0 + d1, y1 = a1 + d1, x2 = a0 + d2, y2 = a1 + d2, x3 = a0 + d3, y3 = a1 + d3;
    asm volatile("ds_read_b64_tr_b16 %0, %8\n\tds_read_b64_tr_b16 %1, %9\n\tds_read_b64_tr_b16 %2, %10\n\tds_read_b64_tr_b16 %3, %11\n\t"
                 "ds_read_b64_tr_b16 %4, %12\n\tds_read_b64_tr_b16 %5, %13\n\tds_read_b64_tr_b16 %6, %14\n\tds_read_b64_tr_b16 %7, %15\n\ts_waitcnt lgkmcnt(0)"
                 : "=&v"(r0), "=&v"(r1), "=&v"(r2), "=&v"(r3), "=&v"(r4), "=&v"(r5), "=&v"(r6), "=&v"(r7)
                 : "v"(x0), "v"(y0), "v"(x1), "v"(y1), "v"(x2), "v"(y2), "v"(x3), "v"(y3) : "memory");
    Frag f; f.u = (u32x4){r0.x, r0.y, r1.x, r1.y}; f0 = f.v; f.u = (u32x4){r2.x, r2.y, r3.x, r3.y}; f1 = f.v;
    f.u = (u32x4){r4.x, r4.y, r5.x, r5.y}; f2 = f.v; f.u = (u32x4){r6.x, r6.y, r7.x, r7.y}; f3 = f.v;
}
#define MFMA16(a, b, c) __builtin_amdgcn_mfma_f32_16x16x32_bf16((a), (b), (c), 0, 0, 0)

namespace pg8 {
constexpr int BM = 256, BK = 64, HALF = 128, HTB = HALF * BK * 2, STAGE_BYTES = 8 * HTB, NXCD = 8, WGM = 8;
__device__ __forceinline__ int lds_byte(int r, int c) { const int st = (r >> 4) * 2 + (c >> 5), rr = r & 15, cc = c & 31, ob = rr * 64 + cc * 2; return st * 1024 + (ob ^ (((ob >> 9) & 1) << 5)); }
__device__ __forceinline__ void stage_rc(int b, int& R, int& C) { const int st = b / 1024, sb = b % 1024, swz = sb ^ (((sb >> 9) & 1) << 5); R = (st >> 1) * 16 + swz / 64; C = (st & 1) * 32 + (swz % 64) / 2; }
__device__ __forceinline__ int perm32(int rho) { const int n = rho >> 4, i = rho & 15; return 8 * (i >> 2) + 4 * n + (i & 3); }
struct Unit { int pm, pn; };
struct Gemm { const bf16_t* A; const bf16_t* Bt; int M, N, K, lda, ldb; int atile = 0; };
struct StaticOrder {
    int nM, nN, nwg, G, c;
    __device__ void init(int M, int N, int G_, int c_) { nM = M / BM; nN = N / BM; nwg = nM * nN; G = G_; c = c_; }
    __device__ bool next(int i, Unit& u) const {
        const long L = (long)i * G + c; if (L >= nwg) return false;
        int wgid = (int)L; { const int q = nwg / NXCD, r = nwg % NXCD, xcd = wgid % NXCD, off = wgid / NXCD; wgid = (xcd < r ? xcd * (q + 1) : r * (q + 1) + (xcd - r) * q) + off; }
        const int nig = WGM * nN, gid = wgid / nig, fm = gid * WGM, gsz = (nM - fm) < WGM ? (nM - fm) : WGM;
        u.pm = fm + ((wgid % nig) % gsz); u.pn = (wgid % nig) / gsz; return true;
    }
    __device__ __forceinline__ void a_ready(const Unit&) const {}
    __device__ __forceinline__ void done(const Unit&) const {}
};

template <class Epi, class Sched>
__device__ __forceinline__ void gemm_phase(const int wv, LAS unsigned char* lds, const Gemm g, const Sched& S, const Epi& E) {
    int tid_ = TIDX; asm volatile("" : "+v"(tid_));
    const int tid = tid_, wid = __builtin_amdgcn_readfirstlane(tid >> 6), lane = tid & 63, wr = wid >> 2, wc = wid & 3, fr = lane & 15, fq = lane >> 4;
    const int K = g.K, nt = K / BK;
    unsigned voffA[2], voffB[2];
#pragma unroll
    for (int i = 0; i < 2; ++i) { int R, C; stage_rc(tid * 16 + i * 8192, R, C); const int Rb = Epi::PERM ? ((R & ~31) + perm32(R & 31)) : R;
        voffA[i] = (unsigned)(R * (g.atile ? BK : g.lda) + C) * 2u; voffB[i] = (unsigned)(Rb * g.ldb + C) * 2u; }
    const size_t kstep = (size_t)(BK * 2);
    const int ldaE = g.atile ? BK : g.lda;
    const size_t kstepA = g.atile ? (size_t)BM * BK * 2 : kstep;
    const size_t hstepA = (size_t)HALF * ldaE * 2, hstepB = (size_t)HALF * g.ldb * 2;
    const size_t tstepA = g.atile ? (size_t)(g.K / BK) * BM * BK * 2 : 2 * hstepA, tstepB = 2 * hstepB;
    const unsigned ldsw = (unsigned)wid * 1024u;
    const int aoff = lds_byte(wr * 64 + fr, fq * 8), boff = lds_byte(wc * 32 + fr, fq * 8);
#define PG8_SA(b, h) (((b) * 2 + (h)) * HTB)
#define PG8_SB(b, h) ((4 + (b) * 2 + (h)) * HTB)
#define PG8_STAGE(bufoff, gbase, voff) do { _Pragma("unroll") for (int _i = 0; _i < 2; ++_i) \
        __builtin_amdgcn_global_load_lds((const unsigned*)((const char*)(gbase) + (voff)[_i]), (LAS unsigned*)(lds + (bufoff) + ldsw + _i * 8192), 16, 0, 0); } while (0)
#define PG8_LDA(dst, b, h) do { _Pragma("unroll") for (int m = 0; m < 4; ++m) _Pragma("unroll") for (int k = 0; k < 2; ++k) dst[m][k] = *(const LAS bf16x8*)(lds + PG8_SA(b, h) + aoff + m * 2048 + k * 1024); } while (0)
#define PG8_LDB(dst, b, h) do { _Pragma("unroll") for (int n = 0; n < 2; ++n) _Pragma("unroll") for (int k = 0; k < 2; ++k) dst[n][k] = *(const LAS bf16x8*)(lds + PG8_SB(b, h) + boff + n * 2048 + k * 1024); } while (0)
#define PG8_MMA(ai, bj, At, Bt) do { __builtin_amdgcn_s_setprio(1); _Pragma("unroll") for (int m = 0; m < 4; ++m) _Pragma("unroll") for (int n = 0; n < 2; ++n) _Pragma("unroll") for (int k = 0; k < 2; ++k) \
        acc[ai][bj][m][n] = __builtin_amdgcn_mfma_f32_16x16x32_bf16(Bt[n][k], At[m][k], acc[ai][bj][m][n], 0, 0, 0); __builtin_amdgcn_s_setprio(0); } while (0)
#define PG8_WAIT_V(n) asm volatile("s_waitcnt vmcnt(" #n ")" ::: "memory")
#define PG8_WAIT_L(n) asm volatile("s_waitcnt lgkmcnt(" #n ")" ::: "memory")
#define PG8_BAR __builtin_amdgcn_s_barrier()
#define PG8_SCHED __builtin_amdgcn_sched_barrier(0)
    Unit cur, nxt; int ui = 0;
    if (!S.next(0, cur)) return;
    f32x4 acc[2][2][4][2];
#pragma unroll
    for (int a = 0; a < 2; ++a)
#pragma unroll
        for (int b = 0; b < 2; ++b)
#pragma unroll
            for (int m = 0; m < 4; ++m)
#pragma unroll
                for (int n = 0; n < 2; ++n) acc[a][b][m][n] = (f32x4){0.f, 0.f, 0.f, 0.f};
    bf16x8 At[4][2], B0[2][2], B1[2][2];
    const char* cA = (const char*)g.A + (size_t)cur.pm * tstepA; const char* cB = (const char*)g.Bt + (size_t)cur.pn * tstepB;
    S.a_ready(cur);
    PG8_STAGE(PG8_SB(0, 0), cB, voffB); PG8_STAGE(PG8_SA(0, 0), cA, voffA); PG8_STAGE(PG8_SB(0, 1), cB + hstepB, voffB); PG8_STAGE(PG8_SA(0, 1), cA + hstepA, voffA);
    if (wr == 1) PG8_BAR;
    PG8_WAIT_V(4); PG8_BAR;
    PG8_STAGE(PG8_SB(1, 0), cB + kstep, voffB); PG8_STAGE(PG8_SA(1, 0), cA + kstepA, voffA); PG8_STAGE(PG8_SB(1, 1), cB + hstepB + kstep, voffB);
    PG8_WAIT_V(6); PG8_BAR;
    for (;;) {
        const bool has_next = S.next(ui + 1, nxt);
        const char* nA = has_next ? (const char*)g.A + (size_t)nxt.pm * tstepA : cA; const char* nB = has_next ? (const char*)g.Bt + (size_t)nxt.pn * tstepB : cB;
        for (int t = 0; t < nt; t += 2) {
            const bool last = (t == nt - 2);
            const char* a1 = cA + (size_t)(t + 1) * kstepA;
            const char* a2 = last ? nA : cA + (size_t)(t + 2) * kstepA; const char* b2 = last ? nB : cB + (size_t)(t + 2) * kstep;
            const char* a3 = a2 + kstepA; const char* b3 = b2 + kstep;
            if (last && has_next) S.a_ready(nxt);
            PG8_LDB(B0, 0, 0); PG8_SCHED; PG8_LDA(At, 0, 0); PG8_STAGE(PG8_SA(1, 1), a1 + hstepA, voffA);
            PG8_WAIT_L(8); PG8_BAR; PG8_WAIT_L(0); PG8_MMA(0, 0, At, B0); PG8_BAR; PG8_SCHED;
            PG8_LDB(B1, 0, 1); PG8_STAGE(PG8_SB(0, 0), b2, voffB);
            PG8_BAR; PG8_WAIT_L(0); PG8_MMA(0, 1, At, B1); PG8_BAR;
            PG8_LDA(At, 0, 1); PG8_STAGE(PG8_SA(0, 0), a2, voffA);
            PG8_BAR; PG8_WAIT_L(0); PG8_MMA(1, 0, At, B0); PG8_BAR; PG8_SCHED;
            PG8_STAGE(PG8_SB(0, 1), b2 + hstepB, voffB);
            PG8_WAIT_V(6); PG8_BAR; PG8_MMA(1, 1, At, B1); PG8_BAR;
            PG8_LDB(B0, 1, 0); PG8_SCHED; PG8_LDA(At, 1, 0); PG8_STAGE(PG8_SA(0, 1), a2 + hstepA, voffA);
            PG8_WAIT_L(8); PG8_BAR; PG8_WAIT_L(0); PG8_MMA(0, 0, At, B0); PG8_BAR; PG8_SCHED;
            PG8_LDB(B1, 1, 1); PG8_STAGE(PG8_SB(1, 0), b3, voffB);
            PG8_BAR; PG8_WAIT_L(0); PG8_MMA(0, 1, At, B1); PG8_BAR;
            PG8_LDA(At, 1, 1); PG8_STAGE(PG8_SA(1, 0), a3, voffA);
            PG8_BAR; PG8_WAIT_L(0); PG8_MMA(1, 0, At, B0); PG8_BAR; PG8_SCHED;
            PG8_STAGE(PG8_SB(1, 1), b3 + hstepB, voffB);
            PG8_WAIT_V(6); PG8_BAR; PG8_MMA(1, 1, At, B1); PG8_BAR;
        }
        E(acc, cur, wr, wc, fr, fq); S.done(cur);
        if (!has_next) break;
#pragma unroll
        for (int a = 0; a < 2; ++a)
#pragma unroll
            for (int b = 0; b < 2; ++b)
#pragma unroll
                for (int m = 0; m < 4; ++m)
#pragma unroll
                    for (int n = 0; n < 2; ++n) acc[a][b][m][n] = (f32x4){0.f, 0.f, 0.f, 0.f};
        cur = nxt; cA = nA; cB = nB; ++ui;
    }
    PG8_WAIT_V(0);
    if (wr == 0) PG8_BAR;
    PG8_BAR;
#undef PG8_SA
#undef PG8_SB
#undef PG8_STAGE
#undef PG8_LDA
#undef PG8_LDB
#undef PG8_MMA
#undef PG8_WAIT_V
#undef PG8_WAIT_L
#undef PG8_BAR
#undef PG8_SCHED
}
}
using pg8::Unit;

struct EpiIn {
    static constexpr bool PERM = true;
    bf16_t* qkvr; bf16_t* gr; bf16_t* gates;
    __device__ __forceinline__ void operator()(const f32x4 (&acc)[2][2][4][2], const Unit& u, int wr, int wc, int fr, int fq) const {
        const int row0 = (u.pm >> 6) * TB + (u.pm & 63) * 256 + wr * 64 + fr; const int pn = u.pn;
        bf16_t* base; int ld, colt, act;
        if (pn < 34) { base = qkvr; ld = QKVR_LD; colt = pn * 256; act = 0; }
        else if (pn < 42) { base = gr; ld = 2048; colt = (pn - 34) * 256; act = 1; }
        else { base = gates; ld = 2048; colt = (pn - 42) * 256; act = 2; }
        const int col0 = colt + wc * 32 + 8 * fq;
        const float lg2k = pn == 22 ? -0.04580368961312479f : (pn == 23 ? -0.02272007650008353f : (pn == 24 ? -0.011315313227834147f : (pn == 25 ? -0.005646563141142062f : 0.0f)));
#pragma unroll
        for (int ai = 0; ai < 2; ++ai)
#pragma unroll
            for (int m = 0; m < 4; ++m) {
                const int row = row0 + ai * 128 + m * 16;
                const float rs = __builtin_amdgcn_exp2f(lg2k * (float)(127 - (row & 127)));
                bf16_t* rowp = base + (size_t)row * ld + col0;
#pragma unroll
                for (int bj = 0; bj < 2; ++bj) {
                    f32x4 v0 = acc[ai][bj][m][0] * rs, v1 = acc[ai][bj][m][1] * rs;
                    if (act == 1) {
#pragma unroll
                        for (int j = 0; j < 4; ++j) { v0[j] = v0[j] * sigmoidf_(v0[j]); v1[j] = v1[j] * sigmoidf_(v1[j]); }
                    } else if (act == 2) {
#pragma unroll
                        for (int j = 0; j < 4; ++j) { v0[j] = sigmoidf_(v0[j]); v1[j] = sigmoidf_(v1[j]); }
                    }
                    u32x4 w; w.x = cvt_pk_bf16(v0[0], v0[1]); w.y = cvt_pk_bf16(v0[2], v0[3]); w.z = cvt_pk_bf16(v1[0], v1[1]); w.w = cvt_pk_bf16(v1[2], v1[3]);
                    *(u32x4*)(rowp + bj * 128) = w;
                }
            }
    }
};
template <int SECOND> struct EpiGate {
    static constexpr bool PERM = true;
    const bf16_t* gates; bf16_t* Y;
    __device__ __forceinline__ void operator()(const f32x4 (&acc)[2][2][4][2], const Unit& u, int wr, int wc, int fr, int fq) const {
        const int row0 = u.pm * 256 + wr * 64 + fr; const int col0 = u.pn * 256 + wc * 32 + 8 * fq;
#pragma unroll
        for (int ai = 0; ai < 2; ++ai) {
            u32x4 gv[4][2], yv[4][2];
#pragma unroll
            for (int m = 0; m < 4; ++m)
#pragma unroll
                for (int bj = 0; bj < 2; ++bj) {
                    const int row = row0 + ai * 128 + m * 16, col = col0 + bj * 128;
                    gv[m][bj] = *(const u32x4*)(gates + (size_t)row * 2048 + SECOND * 1024 + col);
                    if (SECOND) yv[m][bj] = *(const u32x4*)(Y + (size_t)row * 1024 + col);
                }
#pragma unroll
            for (int m = 0; m < 4; ++m)
#pragma unroll
                for (int bj = 0; bj < 2; ++bj) {
                    const int row = row0 + ai * 128 + m * 16, col = col0 + bj * 128;
                    const u32x4 g = gv[m][bj];
                    const f32x4 a0 = acc[ai][bj][m][0], a1 = acc[ai][bj][m][1];
                    float r[8] = {a0[0] * bflo(g.x), a0[1] * bfhi(g.x), a0[2] * bflo(g.y), a0[3] * bfhi(g.y), a1[0] * bflo(g.z), a1[1] * bfhi(g.z), a1[2] * bflo(g.w), a1[3] * bfhi(g.w)};
                    if (SECOND) { const u32x4 y = yv[m][bj];
                        r[0] += bflo(y.x); r[1] += bfhi(y.x); r[2] += bflo(y.y); r[3] += bfhi(y.y); r[4] += bflo(y.z); r[5] += bfhi(y.z); r[6] += bflo(y.w); r[7] += bfhi(y.w); }
                    u32x4 w; w.x = cvt_pk_bf16(r[0], r[1]); w.y = cvt_pk_bf16(r[2], r[3]); w.z = cvt_pk_bf16(r[4], r[5]); w.w = cvt_pk_bf16(r[6], r[7]);
                    *(u32x4*)(Y + (size_t)row * 1024 + col) = w;
                }
        }
    }
};
struct EpiOut {
    static constexpr bool PERM = true;
    const float* x; bf16_t* x1b; float* ss2;
    __device__ __forceinline__ void operator()(const f32x4 (&acc)[2][2][4][2], const Unit& u, int wr, int wc, int fr, int fq) const {
        const int row0 = u.pm * 256 + wr * 64 + fr; const int col0 = u.pn * 256 + wc * 32 + 8 * fq;
#pragma unroll
        for (int ai = 0; ai < 2; ++ai) {
            f32x4 xv[4][2][2];
#pragma unroll
            for (int m = 0; m < 4; ++m)
#pragma unroll
                for (int bj = 0; bj < 2; ++bj) {
                    const size_t o = (size_t)(row0 + ai * 128 + m * 16) * 1024 + col0 + bj * 128;
                    xv[m][bj][0] = *(const f32x4*)(x + o); xv[m][bj][1] = *(const f32x4*)(x + o + 4);
                }
#pragma unroll
            for (int m = 0; m < 4; ++m) {
                const int row = row0 + ai * 128 + m * 16; float ss = 0.f;
#pragma unroll
                for (int bj = 0; bj < 2; ++bj) {
                    const size_t o = (size_t)row * 1024 + col0 + bj * 128;
                    const f32x4 v0 = xv[m][bj][0] + acc[ai][bj][m][0], v1 = xv[m][bj][1] + acc[ai][bj][m][1];
                    ss += (v0[0] * v0[0] + v0[1] * v0[1]) + (v0[2] * v0[2] + v0[3] * v0[3]) + (v1[0] * v1[0] + v1[1] * v1[1]) + (v1[2] * v1[2] + v1[3] * v1[3]);
                    u32x4 w; w.x = cvt_pk_bf16(v0[0], v0[1]); w.y = cvt_pk_bf16(v0[2], v0[3]); w.z = cvt_pk_bf16(v1[0], v1[1]); w.w = cvt_pk_bf16(v1[2], v1[3]);
                    *(u32x4*)(x1b + o) = w;
                }
                ss += shx(ss, fq * 16 + fr, 16); ss += shx(ss, fq * 16 + fr, 32);
                ss2[(size_t)row * 16 + u.pn * 4 + wc] = ss;
            }
        }
    }
};
struct EpiUp {
    static constexpr bool PERM = true;
    const float* ss2; bf16_t* H;
    __device__ __forceinline__ void operator()(const f32x4 (&acc)[2][2][4][2], const Unit& u, int wr, int wc, int fr, int fq) const {
        const int row0 = u.pm * 256 + wr * 64 + fr; const int col0 = u.pn * 256 + wc * 32 + 8 * fq;
        f32x4 sq[2][4];
#pragma unroll
        for (int ai = 0; ai < 2; ++ai)
#pragma unroll
            for (int m = 0; m < 4; ++m) sq[ai][m] = *(const f32x4*)(ss2 + (size_t)(row0 + ai * 128 + m * 16) * 16 + 4 * fq);
#pragma unroll
        for (int ai = 0; ai < 2; ++ai)
#pragma unroll
            for (int m = 0; m < 4; ++m) {
                const int row = row0 + ai * 128 + m * 16;
                float ss = (sq[ai][m][0] + sq[ai][m][1]) + (sq[ai][m][2] + sq[ai][m][3]);
                ss += shx(ss, fq * 16 + fr, 16); ss += shx(ss, fq * 16 + fr, 32);
                const float rs = rsqrtf(ss * (1.0f / 1024.0f) + EPS);
#pragma unroll
                for (int bj = 0; bj < 2; ++bj) {
                    f32x4 v0 = acc[ai][bj][m][0] * rs, v1 = acc[ai][bj][m][1] * rs;
#pragma unroll
                    for (int j = 0; j < 4; ++j) { const float a = fmaxf(v0[j], 0.f), b = fmaxf(v1[j], 0.f); v0[j] = a * a; v1[j] = b * b; }
                    u32x4 w; w.x = cvt_pk_bf16(v0[0], v0[1]); w.y = cvt_pk_bf16(v0[2], v0[3]); w.z = cvt_pk_bf16(v1[0], v1[1]); w.w = cvt_pk_bf16(v1[2], v1[3]);
                    { const int col = col0 + bj * 128;
                      *(u32x4*)(H + ((size_t)((row >> 8) * (DFF / 64) + (col >> 6)) * 256 + (row & 255)) * 64 + (col & 63)) = w; }
                }
            }
    }
};
struct EpiDown {
    static constexpr bool PERM = false;
    const bf16_t* x1b; float* out;
    __device__ __forceinline__ void operator()(const f32x4 (&acc)[2][2][4][2], const Unit& u, int wr, int wc, int fr, int fq) const {
        const int row0 = u.pm * 256 + wr * 64 + fr; const int col0 = u.pn * 256 + wc * 32 + 4 * fq;
        u32x2 xv[2][4][2][2];
#pragma unroll
        for (int ai = 0; ai < 2; ++ai)
#pragma unroll
            for (int m = 0; m < 4; ++m)
#pragma unroll
                for (int bj = 0; bj < 2; ++bj)
#pragma unroll
                    for (int n = 0; n < 2; ++n) xv[ai][m][bj][n] = *(const u32x2*)(x1b + (size_t)(row0 + ai * 128 + m * 16) * 1024 + col0 + bj * 128 + n * 16);
#pragma unroll
        for (int ai = 0; ai < 2; ++ai)
#pragma unroll
            for (int m = 0; m < 4; ++m)
#pragma unroll
                for (int bj = 0; bj < 2; ++bj)
#pragma unroll
                    for (int n = 0; n < 2; ++n) {
                        const size_t o = (size_t)(row0 + ai * 128 + m * 16) * 1024 + col0 + bj * 128 + n * 16;
                        const u32x2 v = xv[ai][m][bj][n]; const f32x4 a = acc[ai][bj][m][n];
                        *(f32x4*)(out + o) = (f32x4){bflo(v.x) + a[0], bfhi(v.x) + a[1], bflo(v.y) + a[2], bfhi(v.y) + a[3]};
                    }
    }
};

struct InProjOrder {
    pg8::StaticOrder so; int G, c, b, gstart, ng;
    __device__ void init(int b_, int G_, int c_) { so.init(TB, 42 * 256, G_, c_); G = G_; c = c_; b = b_; gstart = b_ == 0 ? 0 : 256 + 192 * b_; ng = b_ == 0 ? 448 : 192; }
    __device__ bool next(int i, Unit& u) const {
        const long L = (long)i * G + c;
        if (L < 1344) return so.next(i, u);
        const int gi = (int)L - 1344; if (gi >= ng) return false;
        const int gu = gstart + gi, bq = gu >> 8, wi = gu & 255;
        u.pm = (bq - b) * 64 + (wi >> 3); u.pn = 42 + (wi & 7); return true;
    }
    __device__ __forceinline__ void a_ready(const Unit&) const {}
    __device__ __forceinline__ void done(const Unit&) const {}
};

__device__ __forceinline__ void transpose_w(const int wv, LAS unsigned char* lds, const float* __restrict__ w, bf16_t* __restrict__ wt, int K, int N, const float* __restrict__ gk, int slo, int shi, float scale) {
    const int tk = K / 64, tn = N / 64, nt = tk * tn;
    const int t = TIDX, nl = t & 63, kg = t >> 6, n2 = t >> 3, kc = t & 7;
    for (int tile = blockIdx.x; tile < nt; tile += gridDim.x) {
        const int kt0 = (tile % tk) * 64, nb0 = (tile / tk) * 64;
        const int k0 = kt0 + kg * 8, n = nb0 + nl;
        float v[8];
#pragma unroll
        for (int j = 0; j < 8; ++j) { float g = gk ? gk[k0 + j] : 1.0f; v[j] = w[(size_t)(k0 + j) * N + n] * g; }
        if (n >= slo && n < shi) {
#pragma unroll
            for (int j = 0; j < 8; ++j) v[j] *= scale;
        }
        u32x4 o; o.x = cvt_pk_bf16(v[0], v[1]); o.y = cvt_pk_bf16(v[2], v[3]); o.z = cvt_pk_bf16(v[4], v[5]); o.w = cvt_pk_bf16(v[6], v[7]);
        *(LAS u32x4*)(lds + nl * 144 + kg * 16) = o;
        __syncthreads();
        *(u32x4*)(wt + (size_t)(nb0 + n2) * K + kt0 + kc * 8) = *(const LAS u32x4*)(lds + n2 * 144 + kc * 16);
        __syncthreads();
    }
}
__device__ __forceinline__ void prep_x(const int wv, const float* __restrict__ x, bf16_t* __restrict__ orbuf) {
    const int wave = TIDX >> 6, lane = TIDX & 63;
    const int rstride = gridDim.x * 8;
    for (int row0 = blockIdx.x * 8 + wave; row0 < MT; row0 += 4 * rstride) {
        f32x4 v[4][4];
#pragma unroll
        for (int q = 0; q < 4; ++q) { const int row = row0 + q * rstride;
            if (row < MT) {
#pragma unroll
                for (int i = 0; i < 4; ++i) v[q][i] = *(const f32x4*)(x + (size_t)row * DM + i * 256 + lane * 4);
            } }
#pragma unroll
        for (int q = 0; q < 4; ++q) { const int row = row0 + q * rstride;
            if (row < MT) {
                const int b = row / TB, r = row % TB;
                bf16_t* xo = orbuf + (size_t)b * TB * 2048 + (size_t)r * DM;
                float ss = 0.f;
#pragma unroll
                for (int i = 0; i < 4; ++i) ss += v[q][i][0] * v[q][i][0] + v[q][i][1] * v[q][i][1] + v[q][i][2] * v[q][i][2] + v[q][i][3] * v[q][i][3];
#pragma unroll
                for (int o = 1; o < 64; o <<= 1) ss += shx(ss, lane, o);
                const float rs = rsqrtf(ss * (1.0f / 1024.0f) + EPS);
#pragma unroll
                for (int i = 0; i < 4; ++i) { u32x2 w; w.x = cvt_pk_bf16(v[q][i][0] * rs, v[q][i][1] * rs); w.y = cvt_pk_bf16(v[q][i][2] * rs, v[q][i][3] * rs); *(u32x2*)(xo + i * 256 + lane * 4) = w; }
            } }
    }
}

__device__ __forceinline__ void attn_stream(const int wv, LAS unsigned char* lds, unsigned ldsb, const float* __restrict__ qng, const float* __restrict__ kng, const bf16_t* __restrict__ qkvr, bf16_t* __restrict__ og, float* __restrict__ lse,
                                            int first, int stride, int count) {
    int t_ = TIDX; asm volatile("" : "+v"(t_));
    const int t = t_, w = __builtin_amdgcn_readfirstlane(t >> 6), lane = t & 63, li = lane & 15, g = lane >> 4;
    if (first >= count) return;
    const unsigned QI = 0, KI = 128 * PA;
    const int c16 = t & 15, c160 = t & 15, rr0 = t >> 4, rr = t >> 4;
    u32x4 qr[4], kr[8], vr[8];
#define ATTN_GEOM(item_) const int hh = (item_) >> 6, blk = (item_) & 63; const int grp = hh >> 2, dil = grp == 0 ? 1 : (grp == 1 ? 4 : 16), nb = 64 / dil; const int r = blk / nb, n = blk % nb;
#define ATTN_LOAD_QK(item_) do { ATTN_GEOM(item_) int rr = rr0; asm volatile("" : "+v"(rr)); int c16 = c160; asm volatile("" : "+v"(c16)); \
        _Pragma("unroll") for (int it = 0; it < 4; ++it) { const int row = rr + 32 * it; qr[it] = *(const u32x4*)(qkvr + (size_t)((n * 128 + row) * dil + r) * QKVR_LD + C_AQ + hh * 128 + c16 * 8); } \
        _Pragma("unroll") for (int it = 0; it < 8; ++it) { const int l = n * 128 - 128 + rr + 32 * it; kr[it] = (u32x4){0u, 0u, 0u, 0u}; \
            if (l >= 0) kr[it] = *(const u32x4*)(qkvr + (size_t)(l * dil + r) * QKVR_LD + C_AK + hh * 128 + c16 * 8); } } while (0)
    int item = first;
    ATTN_LOAD_QK(item);
    for (;;) {
        ATTN_GEOM(item)
        const int inext = item + stride;
        {
            float gq[8], gk[8];
            int c8 = c16 * 8; asm volatile("" : "+v"(c8));
#pragma unroll
            for (int j = 0; j < 8; ++j) { gq[j] = qng[hh * 128 + c8 + j] * 0.08838834764831845f; gk[j] = kng[hh * 128 + c8 + j]; }
#pragma unroll
            for (int it = 0; it < 12; ++it) {
                const u32x4 v = it < 4 ? qr[it] : kr[it - 4];
                float f[8] = {bflo(v.x), bfhi(v.x), bflo(v.y), bfhi(v.y), bflo(v.z), bfhi(v.z), bflo(v.w), bfhi(v.w)};
                float ss = 0.f;
#pragma unroll
                for (int j = 0; j < 8; ++j) ss += f[j] * f[j];
                ss += shx(ss, lane, 1); ss += shx(ss, lane, 2); ss += shx(ss, lane, 4); ss += shx(ss, lane, 8);
                const float rs = rsqrtf(ss * (1.0f / 128.0f) + EPS);
#pragma unroll
                for (int j = 0; j < 8; ++j) f[j] *= rs * (it < 4 ? gq[j] : gk[j]);
                u32x4 o; o.x = cvt_pk_bf16(f[0], f[1]); o.y = cvt_pk_bf16(f[2], f[3]); o.z = cvt_pk_bf16(f[4], f[5]); o.w = cvt_pk_bf16(f[6], f[7]);
                if (it < 4) *(LAS u32x4*)(lds + QI + (rr + 32 * it) * PA + c16 * 16) = o;
                else *(LAS u32x4*)(lds + KI + (rr + 32 * (it - 4)) * PA + c16 * 16) = o;
            }
        }
        __syncthreads();
#pragma unroll
        for (int it = 0; it < 8; ++it) { const int l = n * 128 - 128 + rr + 32 * it; vr[it] = (u32x4){0u, 0u, 0u, 0u};
            if (l >= 0) vr[it] = *(const u32x4*)(qkvr + (size_t)(l * dil + r) * QKVR_LD + C_AV + hh * 128 + c16 * 8); }
        bf16x8 qf[4];
#pragma unroll
        for (int s2 = 0; s2 < 4; ++s2) qf[s2] = *(const LAS bf16x8*)(lds + QI + (16 * w + li) * PA + (32 * s2 + 8 * g) * 2);
        f32x4 sc[10];
#pragma unroll
        for (int t3 = 0; t3 < 9; t3 += 3) {
            bf16x8 kf[3][4];
#pragma unroll
            for (int q = 0; q < 3; ++q)
#pragma unroll
                for (int s2 = 0; s2 < 4; ++s2) kf[q][s2] = *(const LAS bf16x8*)(lds + KI + (16 * (w + t3 + q) + li) * PA + (32 * s2 + 8 * g) * 2);
            asm volatile("s_waitcnt lgkmcnt(0)" ::: "memory");
            f32x4 a0 = (f32x4){0.f, 0.f, 0.f, 0.f}, a1 = a0, a2 = a0;
#pragma unroll
            for (int s2 = 0; s2 < 4; ++s2) { a0 = MFMA16(kf[0][s2], qf[s2], a0); a1 = MFMA16(kf[1][s2], qf[s2], a1); a2 = MFMA16(kf[2][s2], qf[s2], a2); }
            sc[t3] = a0; sc[t3 + 1] = a1; sc[t3 + 2] = a2;
        }
        sc[9] = (f32x4){0.f, 0.f, 0.f, 0.f};
        const float slope = exp2f(-8.0f * (float)(hh + 1) / 12.0f) * (float)dil;
        const int qi = 16 * w + li;
        float mx = -3.0e38f;
#pragma unroll
        for (int tt = 0; tt < 9; ++tt)
#pragma unroll
            for (int e = 0; e < 4; ++e) {
                const int kj = 16 * (w + tt) + 4 * g + e; const int dist = 128 + qi - kj;
                const bool valid = (dist >= 0) && (dist <= 128) && (n > 0 || kj >= 128);
                const float sv = valid ? sc[tt][e] - slope * (float)dist : -3.0e38f;
                sc[tt][e] = sv; mx = fmaxf(mx, sv);
            }
        mx = fmaxf(mx, shx(mx, lane, 16)); mx = fmaxf(mx, shx(mx, lane, 32));
        float den = 0.f;
#pragma unroll
        for (int tt = 0; tt < 9; ++tt)
#pragma unroll
            for (int e = 0; e < 4; ++e) { const float sv = sc[tt][e]; const float pv = (sv > -1.0e38f) ? __expf(sv - mx) : 0.f; sc[tt][e] = pv; den += pv; }
        den += shx(den, lane, 16); den += shx(den, lane, 32);
        bf16x8 pf[5];
#pragma unroll
        for (int u = 0; u < 5; ++u) { Frag f; f.u.x = cvt_pk_bf16(sc[2 * u][0], sc[2 * u][1]); f.u.y = cvt_pk_bf16(sc[2 * u][2], sc[2 * u][3]); f.u.z = cvt_pk_bf16(sc[2 * u + 1][0], sc[2 * u + 1][1]); f.u.w = cvt_pk_bf16(sc[2 * u + 1][2], sc[2 * u + 1][3]); pf[u] = f.v; }
        __syncthreads();
#pragma unroll
        for (int it = 0; it < 8; ++it) *(LAS u32x4*)(lds + KI + (rr + 32 * it) * PA + c16 * 16) = vr[it];
        __syncthreads();
        if (inext < count) ATTN_LOAD_QK(inext);
        f32x4 oacc[8];
#pragma unroll
        for (int c = 0; c < 8; ++c) oacc[c] = (f32x4){0.f, 0.f, 0.f, 0.f};
        const int q4 = li >> 2, p4 = lane & 3;
#pragma unroll
        for (int u = 0; u < 5; ++u) {
            int kt0 = w + 2 * u, kt1 = w + 2 * u + 1; kt0 = kt0 > 15 ? 15 : kt0; kt1 = kt1 > 15 ? 15 : kt1;
            const unsigned a0 = ldsb + KI + (16 * kt0 + 4 * g + q4) * PA + 8 * p4;
            const unsigned a1 = ldsb + KI + (16 * kt1 + 4 * g + q4) * PA + 8 * p4;
#pragma unroll
            for (int c = 0; c < 8; c += 4) {
                bf16x8 v0, v1, v2, v3;
                tr_frag4(a0, a1, 32u * c, 32u * (c + 1), 32u * (c + 2), 32u * (c + 3), v0, v1, v2, v3);
                oacc[c] = MFMA16(pf[u], v0, oacc[c]); oacc[c + 1] = MFMA16(pf[u], v1, oacc[c + 1]);
                oacc[c + 2] = MFMA16(pf[u], v2, oacc[c + 2]); oacc[c + 3] = MFMA16(pf[u], v3, oacc[c + 3]);
            }
        }
        if (g == 0) lse[(size_t)((n * 128 + qi) * dil + r) * 12 + hh] = mx + __logf(den);
#pragma unroll
        for (int e = 0; e < 4; ++e) {
            const float inv = 1.0f / shl(den, 4 * g + e);
#pragma unroll
            for (int c = 0; c < 8; ++c) *(LAS bf16_t*)(lds + QI + (16 * w + 4 * g + e) * PA + (16 * c + li) * 2) = f2bf(oacc[c][e] * inv);
        }
        __syncthreads();
#pragma unroll
        for (int k = 0; k < 4; ++k) {
            const int id = t + 512 * k, row = id >> 4, ch = id & 15;
            *(u32x4*)(og + (size_t)((n * 128 + row) * dil + r) * 1536 + hh * 128 + ch * 8) = *(const LAS u32x4*)(lds + QI + row * PA + ch * 16);
        }
        __syncthreads();
        if (inext >= count) break;
        item = inext;
    }
#undef ATTN_GEOM
#undef ATTN_LOAD_QK
}

__device__ __forceinline__ unsigned sw512(unsigned row, unsigned chunk) { return row * 512u + ((chunk ^ (row & 15u)) << 4); }
#define DMA16(gp, lp) __builtin_amdgcn_global_load_lds((const unsigned*)(gp), (LAS unsigned*)(lp), 16, 0, 0)
#define WAITV0() asm volatile("s_waitcnt vmcnt(0)" ::: "memory")
#define LBAR() do { asm volatile("s_waitcnt lgkmcnt(0)" ::: "memory"); __builtin_amdgcn_s_barrier(); asm volatile("" ::: "memory"); } while (0)
__device__ __forceinline__ void tr_frag4x(unsigned x0, unsigned y0, unsigned x1, unsigned y1, unsigned x2, unsigned y2, unsigned x3, unsigned y3, bf16x8& f0, bf16x8& f1, bf16x8& f2, bf16x8& f3) {
    u32x2 r0, r1, r2, r3, r4, r5, r6, r7;
    asm volatile("ds_read_b64_tr_b16 %0, %8\n\tds_read_b64_tr_b16 %1, %9\n\tds_read_b64_tr_b16 %2, %10\n\tds_read_b64_tr_b16 %3, %11\n\t"
                 "ds_read_b64_tr_b16 %4, %12\n\tds_read_b64_tr_b16 %5, %13\n\tds_read_b64_tr_b16 %6, %14\n\tds_read_b64_tr_b16 %7, %15\n\ts_waitcnt lgkmcnt(0)"
                 : "=&v"(r0), "=&v"(r1), "=&v"(r2), "=&v"(r3), "=&v"(r4), "=&v"(r5), "=&v"(r6), "=&v"(r7)
                 : "v"(x0), "v"(y0), "v"(x1), "v"(y1), "v"(x2), "v"(y2), "v"(x3), "v"(y3) : "memory");
    Frag f; f.u = (u32x4){r0.x, r0.y, r1.x, r1.y}; f0 = f.v; f.u = (u32x4){r2.x, r2.y, r3.x, r3.y}; f1 = f.v;
    f.u = (u32x4){r4.x, r4.y, r5.x, r5.y}; f2 = f.v; f.u = (u32x4){r6.x, r6.y, r7.x, r7.y}; f3 = f.v;
}

__device__ __forceinline__ void ret_scan(const int wv, bf16_t* __restrict__ kv) {
    int ts_ = TIDX; asm volatile("" : "+v"(ts_));
    for (int idx = blockIdx.x * 512 + ts_; idx < 4 * 32768; idx += gridDim.x * 512) {
        const int h = idx >> 15, e4 = idx & 32767;
        const float gC = exp2f(128.0f * log2f(1.0f - exp2f(-5.0f - (float)h)));
        bf16_t* pbase = kv + (size_t)h * 64 * 131072 + (size_t)e4 * 4;
        float s0 = 0.f, s1 = 0.f, s2 = 0.f, s3 = 0.f;
#pragma unroll 1
        for (int n0 = 0; n0 < 64; n0 += 8) {
            u32x2 v[8];
#pragma unroll
            for (int k = 0; k < 8; ++k) v[k] = *(const u32x2*)(pbase + (size_t)(n0 + k) * 131072);
#pragma unroll
            for (int k = 0; k < 8; ++k) {
                u32x2 o; o.x = cvt_pk_bf16(s0, s1); o.y = cvt_pk_bf16(s2, s3);
                *(u32x2*)(pbase + (size_t)(n0 + k) * 131072) = o;
                s0 = (s0 + bflo(v[k].x)) * gC; s1 = (s1 + bfhi(v[k].x)) * gC; s2 = (s2 + bflo(v[k].y)) * gC; s3 = (s3 + bfhi(v[k].y)) * gC;
            }
        }
    }
}

__device__ __forceinline__ void retc_stream(const int wv, LAS unsigned char* lds, unsigned ldsb, const float* __restrict__ gn_g, const float* __restrict__ gn_b, const bf16_t* __restrict__ qkvr, const bf16_t* __restrict__ grb, const bf16_t* __restrict__ kv,
                                            bf16_t* __restrict__ orb  , int first, int stride, int count) {
    int t_ = TIDX; asm volatile("" : "+v"(t_));
    const int t = t_, w = __builtin_amdgcn_readfirstlane(t >> 6), lane = t & 63, li = lane & 15, g = lane >> 4;
    if (first >= count) return;
    const size_t RS = (size_t)QKVR_LD * 2;
    const unsigned rsub = (unsigned)w * 2u + ((unsigned)lane >> 5), cc = ((unsigned)lane & 31u) ^ rsub;
    const size_t goffA = (size_t)rsub * RS + cc * 16;
    const size_t goffS = (size_t)rsub * 512 + cc * 16;
    const int q4 = li >> 2, p4 = lane & 3;
#define RETC_ISSUE(item_, s_) do { const int h_ = (item_) >> 6, n_ = (item_) & 63; const unsigned img_ = ((s_) & 1) * 65536u; \
        if ((s_) < 4) { const int col_ = (s_) == 0 ? C_RQ + h_ * 256 : ((s_) == 1 ? C_RK + h_ * 256 : C_RV + h_ * 512 + ((s_) - 2) * 256); \
            const char* gb_ = (const char*)(qkvr + (size_t)(n_ * 128) * QKVR_LD + col_) + goffA; \
            _Pragma("unroll") for (int i_ = 0; i_ < 8; ++i_) DMA16(gb_ + (size_t)i_ * 16 * RS, lds + img_ + i_ * 8192 + w * 1024); } \
        else { const char* gb_ = (const char*)(kv + ((size_t)(h_ * 64 + n_) * 512 + ((s_) - 4) * 128) * 256) + goffS; \
            _Pragma("unroll") for (int i_ = 0; i_ < 8; ++i_) DMA16(gb_ + (size_t)i_ * 16 * 512, lds + img_ + i_ * 8192 + w * 1024); } } while (0)
    unsigned koff[8], toff[8];
#pragma unroll
    for (int s = 0; s < 8; ++s) { koff[s] = (unsigned)li * 512u + ((((unsigned)(4 * s + g)) ^ (unsigned)li) << 4); asm volatile("" : "+v"(koff[s])); }
    { const unsigned xx = (unsigned)(4 * g + q4) & 15u, ph = (unsigned)p4 >> 1, rb = (unsigned)(4 * g + q4) * 512u + 8u * ((unsigned)p4 & 1u);
#pragma unroll
      for (int c = 0; c < 8; ++c) { toff[c] = rb + (((2u * c + ph) ^ xx) << 4); asm volatile("" : "+v"(toff[c])); } }
    int item = first;
    RETC_ISSUE(item, 0);
    for (;;) {
        const int h = item >> 6, n = item & 63;
        const int inext = item + stride;
        const float lg2 = log2f(1.0f - exp2f(-5.0f - (float)h));
        WAITV0(); LBAR(); RETC_ISSUE(item, 1);
        bf16x8 qf[8];
        { unsigned ib = (unsigned)w * 8192u; asm volatile("" : "+v"(ib));
#pragma unroll
        for (int s = 0; s < 8; ++s) qf[s] = *(const LAS bf16x8*)(lds + ib + koff[s]); }
        WAITV0(); LBAR(); RETC_ISSUE(item, 2);
        bf16x8 pf[4];
        {
            f32x4 sc[8];
            const int qi = 16 * w + li;
            unsigned ibk = 65536u; asm volatile("" : "+v"(ibk));
#pragma unroll
            for (int kt = 0; kt < 8; ++kt) {
                f32x4 a = (f32x4){0.f, 0.f, 0.f, 0.f};
                if (kt <= w) {
                    bf16x8 kf[8];
#pragma unroll
                    for (int s = 0; s < 8; ++s) kf[s] = *(const LAS bf16x8*)(lds + ibk + kt * 8192 + koff[s]);
                    asm volatile("s_waitcnt lgkmcnt(0)" ::: "memory");
#pragma unroll
                    for (int s = 0; s < 8; ++s) a = MFMA16(kf[s], qf[s], a);
                }
#pragma unroll
                for (int e = 0; e < 4; ++e) { const int kj = 16 * kt + 4 * g + e; a[e] = (kj <= qi) ? a[e] : 0.f; }
                sc[kt] = a;
            }
#pragma unroll
            for (int u = 0; u < 4; ++u) { Frag f; f.u.x = cvt_pk_bf16(sc[2 * u][0], sc[2 * u][1]); f.u.y = cvt_pk_bf16(sc[2 * u][2], sc[2 * u][3]); f.u.z = cvt_pk_bf16(sc[2 * u + 1][0], sc[2 * u + 1][1]); f.u.w = cvt_pk_bf16(sc[2 * u + 1][2], sc[2 * u + 1][3]); pf[u] = f.v; }
        }
        f32x4 acc[32];
#pragma unroll
        for (int c = 0; c < 32; ++c) acc[c] = (f32x4){0.f, 0.f, 0.f, 0.f};
#pragma unroll
        for (int vh = 0; vh < 2; ++vh) {
            WAITV0(); LBAR(); RETC_ISSUE(item, 3 + vh);
            unsigned imgb = ldsb + vh * 65536u; asm volatile("" : "+v"(imgb));
#pragma unroll
            for (int u = 0; u < 4; ++u) {
                if (2 * u <= w) {
                    const unsigned a0 = imgb + u * 16384u, a1 = a0 + 8192u;
#pragma unroll
                    for (int c = 0; c < 16; c += 4) {
                        bf16x8 v0, v1, v2, v3;
                        const unsigned hi = (c >> 3) * 256u;
                        tr_frag4x(a0 + hi + toff[c & 7], a1 + hi + toff[c & 7], a0 + hi + toff[(c & 7) + 1], a1 + hi + toff[(c & 7) + 1],
                                  a0 + hi + toff[(c & 7) + 2], a1 + hi + toff[(c & 7) + 2], a0 + hi + toff[(c & 7) + 3], a1 + hi + toff[(c & 7) + 3], v0, v1, v2, v3);
                        acc[vh * 16 + c] = MFMA16(pf[u], v0, acc[vh * 16 + c]); acc[vh * 16 + c + 1] = MFMA16(pf[u], v1, acc[vh * 16 + c + 1]);
                        acc[vh * 16 + c + 2] = MFMA16(pf[u], v2, acc[vh * 16 + c + 2]); acc[vh * 16 + c + 3] = MFMA16(pf[u], v3, acc[vh * 16 + c + 3]);
                    }
                }
            }
        }
#pragma unroll
        for (int vc = 0; vc < 4; ++vc) {
            WAITV0(); LBAR();
            if (vc < 3) RETC_ISSUE(item, 5 + vc);
            unsigned img = (vc & 1) * 65536u; asm volatile("" : "+v"(img));
#pragma unroll
            for (int s = 0; s < 8; ++s) {
                bf16x8 bfr[8];
#pragma unroll
                for (int c = 0; c < 8; ++c) bfr[c] = *(const LAS bf16x8*)(lds + img + c * 8192 + koff[s]);
                asm volatile("s_waitcnt lgkmcnt(0)" ::: "memory");
#pragma unroll
                for (int c = 0; c < 8; ++c) acc[vc * 8 + c] = MFMA16(qf[s], bfr[c], acc[vc * 8 + c]);
            }
        }
        const float* gng = gn_g + h * 512; const float* gnb = gn_b + h * 512;
        float mu4[4], rs4[4];
#pragma unroll
        for (int e = 0; e < 4; ++e) {
            const int q = 16 * w + 4 * g + e;
            const float xi = exp2f(lg2 * (float)(q - 127));
            float sum = 0.f;
#pragma unroll
            for (int c = 0; c < 32; ++c) { acc[c][e] *= xi; sum += acc[c][e]; }
            sum += shx(sum, lane, 1); sum += shx(sum, lane, 2); sum += shx(sum, lane, 4); sum += shx(sum, lane, 8);
            const float mu = sum * (1.0f / 512.0f);
            float var = 0.f;
#pragma unroll
            for (int c = 0; c < 32; ++c) { const float d = acc[c][e] - mu; var += d * d; }
            var += shx(var, lane, 1); var += shx(var, lane, 2); var += shx(var, lane, 4); var += shx(var, lane, 8);
            mu4[e] = mu; rs4[e] = rsqrtf(var * (1.0f / 512.0f) + EPS);
        }
        LBAR();
        {
            unsigned wb = (unsigned)(16 * w + 4 * g) * 1024u + (unsigned)li * 2u; asm volatile("" : "+v"(wb));
#pragma unroll
            for (int c = 0; c < 32; ++c) {
                const unsigned co = (unsigned)(((2 * c) ^ (2 * g)) * 16);
#pragma unroll
                for (int e = 0; e < 4; ++e)
                    *(LAS bf16_t*)(lds + wb + e * 1024 + co) = f2bf((acc[c][e] - mu4[e]) * rs4[e]);
            }
        }
        {
            int tq = t; asm volatile("" : "+v"(tq));
            const int ch = tq & 63, r0 = tq >> 6;
            const f32x4 g0 = *(const f32x4*)(gng + ch * 8), g1 = *(const f32x4*)(gng + ch * 8 + 4), b0 = *(const f32x4*)(gnb + ch * 8), b1 = *(const f32x4*)(gnb + ch * 8 + 4);
            u32x4 gv[16];
#pragma unroll
            for (int k = 0; k < 16; ++k) gv[k] = *(const u32x4*)(grb + (size_t)(n * 128 + r0 + 8 * k) * 2048 + h * 512 + ch * 8);
            LBAR();
#pragma unroll
            for (int k = 0; k < 16; ++k) {
                const int row = r0 + 8 * k;
                const u32x4 yv = *(const LAS u32x4*)(lds + row * 1024 + ((ch ^ (2 * ((row >> 2) & 3))) << 4));
                const u32x4 q = gv[k];
                u32x4 o;
                o.x = cvt_pk_bf16((bflo(yv.x) * g0[0] + b0[0]) * bflo(q.x), (bfhi(yv.x) * g0[1] + b0[1]) * bfhi(q.x));
                o.y = cvt_pk_bf16((bflo(yv.y) * g0[2] + b0[2]) * bflo(q.y), (bfhi(yv.y) * g0[3] + b0[3]) * bfhi(q.y));
                o.z = cvt_pk_bf16((bflo(yv.z) * g1[0] + b1[0]) * bflo(q.z), (bfhi(yv.z) * g1[1] + b1[1]) * bfhi(q.z));
                o.w = cvt_pk_bf16((bflo(yv.w) * g1[2] + b1[2]) * bflo(q.w), (bfhi(yv.w) * g1[3] + b1[3]) * bfhi(q.w));
                *(u32x4*)(orb + (size_t)(n * 128 + row) * 2048 + h * 512 + ch * 8) = o;
            }
        }
        if (inext >= count) break;
        LBAR();
        RETC_ISSUE(inext, 0);
        item = inext;
    }
#undef RETC_ISSUE
    WAITV0(); LBAR();
}

__device__ __forceinline__ void reta_item(const int wv, LAS unsigned char* lds, unsigned ldsb, const bf16_t* __restrict__ qkvr, bf16_t* __restrict__ kv, int j) {
    const int h = j >> 7, n = (j >> 1) & 63, vh = j & 1;
    int t_ = TIDX; asm volatile("" : "+v"(t_));
    const int t = t_, w = __builtin_amdgcn_readfirstlane(t >> 6), lane = t & 63, li = lane & 15, g = lane >> 4;
    const unsigned VI = 0, KI = 128 * PR;
    const float lg2 = log2f(1.0f - exp2f(-5.0f - (float)h));
    {
        const int c = t & 31, rr = t >> 5;
#pragma unroll
        for (int it = 0; it < 8; ++it) {
            const int row = rr + 16 * it; const size_t tokoff = (size_t)(n * 128 + row) * QKVR_LD;
            const u32x4 kvv = *(const u32x4*)(qkvr + tokoff + C_RK + h * 256 + c * 8);
            *(LAS u32x4*)(lds + KI + row * PR + c * 16) = kvv;
            const u32x4 v = *(const u32x4*)(qkvr + tokoff + C_RV + h * 512 + vh * 256 + c * 8);
            const float z = 1.0f;
            u32x4 o; o.x = cvt_pk_bf16(bflo(v.x) * z, bfhi(v.x) * z); o.y = cvt_pk_bf16(bflo(v.y) * z, bfhi(v.y) * z);
            o.z = cvt_pk_bf16(bflo(v.z) * z, bfhi(v.z) * z); o.w = cvt_pk_bf16(bflo(v.w) * z, bfhi(v.w) * z);
            *(LAS u32x4*)(lds + VI + row * PR + c * 16) = o;
        }
    }
    __syncthreads();
    const int wm = w >> 1, wn = w & 1;
    const int q4 = (lane & 15) >> 2, p4 = lane & 3;
    f32x4 acc[4][8];
#pragma unroll
    for (int mi = 0; mi < 4; ++mi)
#pragma unroll
        for (int ci = 0; ci < 8; ++ci) acc[mi][ci] = (f32x4){0.f, 0.f, 0.f, 0.f};
#pragma unroll 1
    for (int ks = 0; ks < 4; ++ks) {
        const unsigned r0 = (32 * ks + 8 * g + q4) * PR + 8 * p4, r1 = r0 + 4 * PR;
        bf16x8 af[4];
        tr_frag4(ldsb + KI + r0 + 128 * wm, ldsb + KI + r1 + 128 * wm, 0u, 32u, 64u, 96u, af[0], af[1], af[2], af[3]);
#pragma unroll
        for (int ci = 0; ci < 8; ci += 4) {
            bf16x8 b0, b1, b2, b3;
            tr_frag4(ldsb + VI + r0 + 256 * wn, ldsb + VI + r1 + 256 * wn, 32u * ci, 32u * (ci + 1), 32u * (ci + 2), 32u * (ci + 3), b0, b1, b2, b3);
#pragma unroll
            for (int mi = 0; mi < 4; ++mi) {
                acc[mi][ci] = MFMA16(af[mi], b0, acc[mi][ci]); acc[mi][ci + 1] = MFMA16(af[mi], b1, acc[mi][ci + 1]);
                acc[mi][ci + 2] = MFMA16(af[mi], b2, acc[mi][ci + 2]); acc[mi][ci + 3] = MFMA16(af[mi], b3, acc[mi][ci + 3]);
            }
        }
    }
    bf16_t* base = kv + ((size_t)(h * 64 + n) * 512 + vh * 256) * 256;
    __syncthreads();
#pragma unroll
    for (int mi = 0; mi < 4; ++mi)
#pragma unroll
        for (int ci = 0; ci < 8; ++ci) {
            u32x2 o; o.x = cvt_pk_bf16(acc[mi][ci][0], acc[mi][ci][1]); o.y = cvt_pk_bf16(acc[mi][ci][2], acc[mi][ci][3]);
            *(LAS u32x2*)(lds + (128 * wn + 16 * ci + li) * PR + (64 * wm + 16 * mi + 4 * g) * 2) = o;
        }
    __syncthreads();
#pragma unroll 4
    for (int k = 0; k < 16; ++k) {
        const int id = t + 512 * k, row = id >> 5, ch = id & 31;
        *(u32x4*)(base + (size_t)row * 256 + ch * 8) = *(const LAS u32x4*)(lds + row * PR + ch * 16);
    }
    __syncthreads();
}

__device__ __forceinline__ void attn_combine(const int wv, const bf16_t* __restrict__ og, const float* __restrict__ lse, bf16_t* __restrict__ oa  ) {
    int tc_ = TIDX; asm volatile("" : "+v"(tc_));
    const int stride = gridDim.x * 512;
    for (int idx0 = blockIdx.x * 512 + tc_; idx0 < TB * 64; idx0 += 4 * stride) {
        float l[4][3]; u32x4 v[4][3];
#pragma unroll
        for (int q = 0; q < 4; ++q) {
            const int idx = idx0 + q * stride;
            if (idx < TB * 64) {
                const int tok = idx >> 6, hs = (idx >> 4) & 3, c = idx & 15;
#pragma unroll
                for (int gi = 0; gi < 3; ++gi) { l[q][gi] = lse[tok * 12 + 4 * gi + hs]; v[q][gi] = *(const u32x4*)(og + (size_t)tok * 1536 + (4 * gi + hs) * 128 + c * 8); }
            }
        }
#pragma unroll
        for (int q = 0; q < 4; ++q) {
            const int idx = idx0 + q * stride;
            if (idx < TB * 64) {
                const int tok = idx >> 6, hs = (idx >> 4) & 3, c = idx & 15;
                const float m = fmaxf(l[q][0], fmaxf(l[q][1], l[q][2]));
                float a0 = __expf(l[q][0] - m), a1 = __expf(l[q][1] - m), a2 = __expf(l[q][2] - m);
                const float inv = __builtin_amdgcn_rcpf(a0 + a1 + a2); a0 *= inv; a1 *= inv; a2 *= inv;
                const u32x4 v0 = v[q][0], v1 = v[q][1], v2 = v[q][2];
                u32x4 o;
                o.x = cvt_pk_bf16(a0 * bflo(v0.x) + a1 * bflo(v1.x) + a2 * bflo(v2.x), a0 * bfhi(v0.x) + a1 * bfhi(v1.x) + a2 * bfhi(v2.x));
                o.y = cvt_pk_bf16(a0 * bflo(v0.y) + a1 * bflo(v1.y) + a2 * bflo(v2.y), a0 * bfhi(v0.y) + a1 * bfhi(v1.y) + a2 * bfhi(v2.y));
                o.z = cvt_pk_bf16(a0 * bflo(v0.z) + a1 * bflo(v1.z) + a2 * bflo(v2.z), a0 * bfhi(v0.z) + a1 * bfhi(v1.z) + a2 * bfhi(v2.z));
                o.w = cvt_pk_bf16(a0 * bflo(v0.w) + a1 * bflo(v1.w) + a2 * bflo(v2.w), a0 * bfhi(v0.w) + a1 * bfhi(v1.w) + a2 * bfhi(v2.w));
                *(u32x4*)(oa + (size_t)tok * 512 + hs * 128 + c * 8) = o;
            }
        }
    }
}


#define XB_TMO      128
#define XB_XCNT(j)  (256  + 64 * (j))
#define XB_XSUB(j)  (1280 + 64 * (j))
#define XB_XGEN(j)  (2304 + 64 * (j))
#define XB_TOP      3328
#define XB_TOPGEN   3392
#define XCD_BAR_WORDS 3456
#define XB_SPIN_CAP (1u << 22)
__device__ __forceinline__ unsigned xb_ld(unsigned* p)              { return __hip_atomic_load(p, __ATOMIC_RELAXED, __HIP_MEMORY_SCOPE_AGENT); }
__device__ __forceinline__ unsigned xb_add(unsigned* p, unsigned v) { return __hip_atomic_fetch_add(p, v, __ATOMIC_RELAXED, __HIP_MEMORY_SCOPE_AGENT); }
__device__ __forceinline__ unsigned xb_xcc_id() { return (unsigned)__builtin_amdgcn_s_getreg((3 << 11) | 20) & 0xFu; }
#define XB_SPIN(cond, bar) do { unsigned _sp = 0; while (cond) { __builtin_amdgcn_s_sleep(1); \
    if ((++_sp & 255u) == 0u) { if (xb_ld(&(bar)[XB_TMO])) break; if (_sp > XB_SPIN_CAP) { atomicAdd(&(bar)[XB_TMO], 1u); break; } } } } while (0)
struct XcdBarrier { unsigned* bar; unsigned x; volatile LAS unsigned* st; };
__device__ __forceinline__ XcdBarrier xcd_barrier_post(const int wv, unsigned* bar, volatile LAS unsigned* st) {
    XcdBarrier b; b.bar = bar; b.x = xb_xcc_id(); b.st = st;
    if (TIDX == 0) (void)xb_add(&bar[XB_XCNT(b.x)], 1u);
    return b;
}
__device__ __forceinline__ void xcd_barrier_complete(unsigned* bar, unsigned x, unsigned& nloc, unsigned& nx) {
    const unsigned G = gridDim.x * gridDim.y * gridDim.z;
    unsigned sum, cnt, mine, sp = 0u;
    for (;;) {
        sum = 0u; cnt = 0u; mine = 0u;
#pragma unroll
        for (unsigned j = 0; j < 16; ++j) { const unsigned c = xb_ld(&bar[XB_XCNT(j)]); sum += c; cnt += (c > 0u) ? 1u : 0u; mine = (j == x) ? c : mine; }
        if (sum == G) break;
        __builtin_amdgcn_s_sleep(1);
        if ((++sp & 255u) == 0u) { if (xb_ld(&bar[XB_TMO])) break; if (sp > XB_SPIN_CAP) { atomicAdd(&bar[XB_TMO], 1u); break; } }
    }
    nloc = mine > 0u ? mine : 1u; nx = cnt > 0u ? cnt : 1u;
}
__device__ __forceinline__ void xcd_barrier(const int wv, const XcdBarrier& b) {
    asm volatile("s_waitcnt vmcnt(0)" ::: "memory");
    __syncthreads();
    if (TIDX == 0) {
        unsigned long long barq = (unsigned long long)b.bar; asm volatile("" : "+s"(barq));
        unsigned* bar = (unsigned*)barq;
        __builtin_amdgcn_s_waitcnt(0);
        unsigned nloc = b.st[0], nx = b.st[1];
        if (nloc == 0u) { xcd_barrier_complete(bar, b.x, nloc, nx); b.st[0] = nloc; b.st[1] = nx; }
        const unsigned old = xb_add(&bar[XB_XSUB(b.x)], 1u);
        const unsigned gen = old / nloc;
        if (old + 1u == (gen + 1u) * nloc) {
            __builtin_amdgcn_fence(__ATOMIC_RELEASE, "agent");
            asm volatile("s_waitcnt vmcnt(0)" ::: "memory");
            const unsigned og = xb_add(&bar[XB_TOP], 1u);
            const unsigned tg = og / nx;
            if (og + 1u == (tg + 1u) * nx) xb_add(&bar[XB_TOPGEN], 1u);
            else XB_SPIN(xb_ld(&bar[XB_TOPGEN]) == tg, bar);
            __builtin_amdgcn_fence(__ATOMIC_ACQUIRE, "agent");
            xb_add(&bar[XB_XGEN(b.x)], 1u);
            asm volatile("s_waitcnt vmcnt(0)" ::: "memory");
        } else {
            XB_SPIN(xb_ld(&bar[XB_XGEN(b.x)]) == gen, bar);
            __builtin_amdgcn_fence(__ATOMIC_ACQUIRE, "agent");
            asm volatile("s_waitcnt vmcnt(0)" ::: "memory");
        }
    }
    __syncthreads();
}

typedef const __attribute__((address_space(4))) Params* KParams;
__device__ __forceinline__ KParams kparams() { unsigned long long a = (unsigned long long)__builtin_amdgcn_kernarg_segment_ptr(); asm volatile("" : "+s"(a)); return (KParams)a; }

__global__ void __launch_bounds__(512, 2) mega(Params p_unused) {
    extern __shared__ __attribute__((aligned(16))) unsigned char shm[];
    LAS unsigned char* lds = (LAS unsigned char*)shm;
    const unsigned ldsb = (unsigned)(size_t)lds;
    const int wv = __builtin_amdgcn_readfirstlane((int)(threadIdx.x >> 6));
    cg::grid_group grid = cg::this_grid();
    volatile LAS unsigned* xst = (volatile LAS unsigned*)(lds + LDS_BYTES - 16);
    if (TIDX == 0) { xst[0] = 0u; xst[1] = 0u; }
    __syncthreads();
    const XcdBarrier xb = xcd_barrier_post(wv, (unsigned*)(kparams()->ws + WS_BAR), xst);
#define GSYNC() xcd_barrier(wv, xb)
#define WSP(T, off) ((T*)(ws + (off)))

    {
        KParams kp = kparams(); unsigned char* ws = kp->ws;
        transpose_w(wv, lds, kp->w_in, WSP(bf16_t, WS_WIN), DM, INW, kp->norm1_g, C_RK, C_RK + 1024, 0.0625f);
        transpose_w(wv, lds, kp->w_pa, WSP(bf16_t, WS_WPA), 512, DM, nullptr, 0, 0, 1.f);
        transpose_w(wv, lds, kp->w_pb, WSP(bf16_t, WS_WPB), 2048, DM, nullptr, 0, 0, 1.f);
        transpose_w(wv, lds, kp->w_out, WSP(bf16_t, WS_WOUT), DM, DM, nullptr, 0, 0, 1.f);
        transpose_w(wv, lds, kp->w_up, WSP(bf16_t, WS_WUP), DM, DFF, kp->norm2_g, 0, 0, 1.f);
        transpose_w(wv, lds, kp->w_dn, WSP(bf16_t, WS_WDN), DFF, DM, nullptr, 0, 0, 1.f);
        prep_x(wv, kp->x, WSP(bf16_t, WS_OR));
    }
    if (kparams()->ws == nullptr) grid.sync();
    GSYNC();

    for (int b = 0; b < 4; ++b) {
        {
            KParams kp = kparams(); unsigned char* ws = kp->ws;
            pg8::Gemm gm{WSP(bf16_t, WS_OR) + (size_t)b * TB * 2048, WSP(bf16_t, WS_WIN), TB, INW, DM, DM, DM};
            InProjOrder S; S.init(b, (int)gridDim.x, (int)blockIdx.x);
            EpiIn E{WSP(bf16_t, WS_R0), WSP(bf16_t, WS_GR), (bf16_t*)kp->out + (size_t)b * TB * 2048};
            pg8::gemm_phase<EpiIn, InProjOrder>(wv, lds, gm, S, E);
        }
        GSYNC();
        {
            KParams kp = kparams(); unsigned char* ws = kp->ws;
            attn_stream(wv, lds, ldsb, kp->q_norm_g, kp->k_norm_g, WSP(bf16_t, WS_R0), WSP(bf16_t, WS_OG), WSP(float, WS_LSE), (int)blockIdx.x, (int)gridDim.x, 768);
        }
        {
            KParams kp = kparams(); unsigned char* ws = kp->ws;
            for (int j = blockIdx.x; j < 512; j += gridDim.x) reta_item(wv, lds, ldsb, WSP(bf16_t, WS_R0), WSP(bf16_t, WS_KV), j);
        }
        GSYNC();
        { KParams kp = kparams(); unsigned char* ws = kp->ws; ret_scan(wv, WSP(bf16_t, WS_KV)); }
        GSYNC();
        {
            KParams kp = kparams(); unsigned char* ws = kp->ws;
            retc_stream(wv, lds, ldsb, kp->gn_g, kp->gn_b, WSP(bf16_t, WS_R0), WSP(bf16_t, WS_GR), WSP(bf16_t, WS_KV), WSP(bf16_t, WS_OR) + (size_t)b * TB * 2048, (int)blockIdx.x, (int)gridDim.x, 256);
        }
        {
            KParams kp = kparams(); unsigned char* ws = kp->ws;
            attn_combine(wv, WSP(bf16_t, WS_OG), WSP(float, WS_LSE), WSP(bf16_t, WS_OA) + (size_t)b * TB * 512);
        }
        GSYNC();
    }
    {
        KParams kp = kparams(); unsigned char* ws = kp->ws;
        pg8::StaticOrder S; S.init(MT, DM, (int)gridDim.x, (int)blockIdx.x);
        { pg8::Gemm gm{WSP(bf16_t, WS_OA), WSP(bf16_t, WS_WPA), MT, DM, 512, 512, 512}; EpiGate<0> E{(const bf16_t*)kp->out, WSP(bf16_t, WS_Y)}; pg8::gemm_phase<EpiGate<0>, pg8::StaticOrder>(wv, lds, gm, S, E); }
        { pg8::Gemm gm{WSP(bf16_t, WS_OR), WSP(bf16_t, WS_WPB), MT, DM, 2048, 2048, 2048}; EpiGate<1> E{(const bf16_t*)kp->out, WSP(bf16_t, WS_Y)}; pg8::gemm_phase<EpiGate<1>, pg8::StaticOrder>(wv, lds, gm, S, E); }
    }
    GSYNC();
    {
        KParams kp = kparams(); unsigned char* ws = kp->ws;
        pg8::StaticOrder S; S.init(MT, DM, (int)gridDim.x, (int)blockIdx.x);
        pg8::Gemm gm{WSP(bf16_t, WS_Y), WSP(bf16_t, WS_WOUT), MT, DM, DM, DM, DM}; EpiOut E{kp->x, WSP(bf16_t, WS_X1B), WSP(float, WS_SS2)};
        pg8::gemm_phase<EpiOut, pg8::StaticOrder>(wv, lds, gm, S, E);
    }
    GSYNC();
    {
        KParams kp = kparams(); unsigned char* ws = kp->ws;
        pg8::StaticOrder S; S.init(MT, DFF, (int)gridDim.x, (int)blockIdx.x);
        pg8::Gemm gm{WSP(bf16_t, WS_X1B), WSP(bf16_t, WS_WUP), MT, DFF, DM, DM, DM}; EpiUp E{WSP(float, WS_SS2), WSP(bf16_t, WS_H)};
        pg8::gemm_phase<EpiUp, pg8::StaticOrder>(wv, lds, gm, S, E);
    }
    GSYNC();
    {
        KParams kp = kparams(); unsigned char* ws = kp->ws;
        pg8::StaticOrder S; S.init(MT, DM, (int)gridDim.x, (int)blockIdx.x);
        pg8::Gemm gm{WSP(bf16_t, WS_H), WSP(bf16_t, WS_WDN), MT, DM, DFF, DFF, DFF, 1}; EpiDown E{WSP(bf16_t, WS_X1B), kp->out};
        pg8::gemm_phase<EpiDown, pg8::StaticOrder>(wv, lds, gm, S, E);
    }
}

extern "C" void kernel_launch(void* const* d_in, const int* in_sizes, int n_in, void* d_out, int out_size, void* d_ws, size_t ws_size, hipStream_t stream) {
    static int grid_blocks = 0;
    if (grid_blocks == 0) {
        if (ws_size < WS_END) { fprintf(stderr, "kernel_launch: workspace too small: %zu < %zu\n", ws_size, (size_t)WS_END); grid_blocks = -1; return; }
        int dev = 0, cus = 0, per_cu = 0;
        hipGetDevice(&dev);
        hipDeviceGetAttribute(&cus, hipDeviceAttributeMultiprocessorCount, dev);
        if (hipFuncSetAttribute((const void*)mega, hipFuncAttributeMaxDynamicSharedMemorySize, LDS_BYTES) != hipSuccess) { fprintf(stderr, "kernel_launch: hipFuncSetAttribute failed\n"); grid_blocks = -1; return; }
        if (hipOccupancyMaxActiveBlocksPerMultiprocessor(&per_cu, (const void*)mega, 512, LDS_BYTES) != hipSuccess || per_cu < 1) { fprintf(stderr, "kernel_launch: occupancy query failed (%d)\n", per_cu); per_cu = 1; (void)hipGetLastError(); }
        grid_blocks = cus * per_cu;
    }
    if (grid_blocks < 0) return;
    Params p{};
    p.x = (const float*)d_in[0]; p.norm1_g = (const float*)d_in[1]; p.w_in = (const float*)d_in[2]; p.q_norm_g = (const float*)d_in[3]; p.k_norm_g = (const float*)d_in[4];
    p.gn_g = (const float*)d_in[5]; p.gn_b = (const float*)d_in[6]; p.w_pa = (const float*)d_in[7]; p.w_pb = (const float*)d_in[8]; p.w_out = (const float*)d_in[9];
    p.norm2_g = (const float*)d_in[10]; p.w_up = (const float*)d_in[11]; p.w_dn = (const float*)d_in[12];
    p.out = (float*)d_out; p.ws = (unsigned char*)d_ws;
    if (hipMemsetAsync((char*)d_ws + WS_BAR, 0, XCD_BAR_WORDS * 4, stream) != hipSuccess) { fprintf(stderr, "kernel_launch: memset failed\n"); return; }
    void* args[] = {&p};
    hipError_t e = hipLaunchCooperativeKernel((const void*)mega, dim3(grid_blocks), dim3(512), args, LDS_BYTES, stream);
    if (e != hipSuccess) fprintf(stderr, "cooperative launch failed: %s (grid %d)\n", hipGetErrorString(e), grid_blocks);
}
```
